# Optimizing an MI355X kernel written in HIP

```python
import jax, jax.numpy as jnp
from jax import lax
import numpy as np

D_MODEL = 1024
BATCH = 2
SEQ = 8192
DEPTH = 1
DEC_BATCH = 32
DEC_SEQ = 32
PAST_LEN = 1024

CHUNK = 64
HEAD_DIM = 64
CONV_DIM = 256
CONV_K = 3
FOX_HEADS = 8
FOX_DIM = FOX_HEADS * HEAD_DIM
MEM_HEADS = 4
MEM_DIM = MEM_HEADS * HEAD_DIM
N_MEM = 256
MIX_DIM = CONV_DIM + FOX_DIM + MEM_DIM
IN_COLS = 3 * CONV_DIM + 3 * FOX_DIM + FOX_HEADS + MEM_DIM
D_FF = 2816
Q_BLOCK = 128
EPS = 1e-6
F32 = jnp.float32

kernel_name = 'hybrid_streaming_conv_fox_memory_step'


def _rmsnorm(x, g):
    xf = x.astype(F32)
    y = xf * lax.rsqrt(jnp.mean(xf * xf, axis=-1, keepdims=True) + EPS)
    return (y * g.astype(F32)).astype(x.dtype)


def _head_rms(x, g):
    return _rmsnorm(x, g)


def _swiglu(x, w_gate, w_up, w_down):
    return (jax.nn.silu(x @ w_gate) * (x @ w_up)) @ w_down


def _fox_attention(q, k, v, cum_q, cum_k, q_offset):
    bsz, tq, nh, dh = q.shape
    tk = k.shape[1]
    kpos = jnp.arange(tk)
    cum_k_t = jnp.swapaxes(cum_k, 1, 2)
    scale = dh ** -0.5

    def block(args):
        qb, cqb, qpos = args
        s = jnp.einsum('bqhd,bkhd->bhqk', qb, k).astype(F32) * scale
        s = s + jnp.swapaxes(cqb, 1, 2)[..., :, None] - cum_k_t[..., None, :]
        s = jnp.where(kpos[None, :] <= qpos[:, None], s, -jnp.inf)
        p = jax.nn.softmax(s, axis=-1)
        return jnp.einsum('bhqk,bkhd->bqhd', p.astype(v.dtype), v)

    qpos = q_offset + jnp.arange(tq)
    if tq <= Q_BLOCK:
        return block((q, cum_q, qpos))
    nb = tq // Q_BLOCK
    qb = q.reshape(bsz, nb, Q_BLOCK, nh, dh).transpose(1, 0, 2, 3, 4)
    cqb = cum_q.reshape(bsz, nb, Q_BLOCK, nh).transpose(1, 0, 2, 3)
    pb = qpos.reshape(nb, Q_BLOCK)
    out = lax.map(block, (qb, cqb, pb))
    return out.transpose(1, 0, 2, 3, 4).reshape(bsz, tq, nh, dh)


def _mem_attention(q, k, v):
    s = jnp.einsum('bqhd,bkhd->bhqk', q, k).astype(F32) * (HEAD_DIM ** -0.5)
    p = jax.nn.softmax(s, axis=-1)
    return jnp.einsum('bhqk,bkhd->bqhd', p.astype(v.dtype), v)


def _mem_kv(mem, g_mem, w_mem_kv, gk_mem):
    bsz, n, _ = mem.shape
    kv = _rmsnorm(mem, g_mem) @ w_mem_kv
    mk, mv = jnp.split(kv, [MEM_DIM], axis=-1)
    mk = _head_rms(mk.reshape(bsz, n, MEM_HEADS, HEAD_DIM), gk_mem)
    return mk, mv.reshape(bsz, n, MEM_HEADS, HEAD_DIM)


def _layer(x, conv_prev, past_k, past_v, past_logf, mem_k, mem_v, lp):
    (g_f1, w_g1, w_u1, w_d1, g_mix, w_in, b_f, conv_w, conv_b,
     gq_fox, gk_fox, gq_mem, w_out, g_f2, w_g2, w_u2, w_d2, g_fin) = lp
    bsz, t, _ = x.shape
    x = x + 0.5 * _swiglu(_rmsnorm(x, g_f1), w_g1, w_u1, w_d1)
    h = _rmsnorm(x, g_mix)
    proj = h @ w_in
    bounds = np.cumsum([CONV_DIM, CONV_DIM, CONV_DIM, FOX_DIM, FOX_DIM, FOX_DIM, FOX_HEADS]).tolist()
    u, c_gate, b_gate, q, k, v, f_logit, q_mem = jnp.split(proj, bounds, axis=-1)
    conv_in = c_gate * u
    padded = jnp.concatenate([conv_prev.astype(conv_in.dtype), conv_in], axis=1)
    conv = conv_b + conv_w[CONV_K - 1] * padded[:, CONV_K - 1:CONV_K - 1 + t]
    for i in range(CONV_K - 1):
        conv = conv + conv_w[i] * padded[:, i:i + t]
    y_conv = b_gate * conv
    new_conv = padded[:, t:]
    q = _head_rms(q.reshape(bsz, t, FOX_HEADS, HEAD_DIM), gq_fox)
    k = _head_rms(k.reshape(bsz, t, FOX_HEADS, HEAD_DIM), gk_fox)
    v = v.reshape(bsz, t, FOX_HEADS, HEAD_DIM)
    logf = jax.nn.log_sigmoid(f_logit.astype(F32) + b_f.astype(F32))
    p_len = past_k.shape[1]
    k_all = jnp.concatenate([past_k.astype(k.dtype), k], axis=1)
    v_all = jnp.concatenate([past_v.astype(v.dtype), v], axis=1)
    cum = jnp.cumsum(jnp.concatenate([past_logf.astype(F32), logf], axis=1), axis=1)
    y_fox = _fox_attention(q, k_all, v_all, cum[:, p_len:], cum, p_len)
    q_mem = _head_rms(q_mem.reshape(bsz, t, MEM_HEADS, HEAD_DIM), gq_mem)
    y_mem = _mem_attention(q_mem, mem_k.astype(q_mem.dtype), mem_v.astype(q_mem.dtype))
    mix = jnp.concatenate([y_conv, y_fox.reshape(bsz, t, FOX_DIM), y_mem.reshape(bsz, t, MEM_DIM)], axis=-1)
    x = x + mix @ w_out
    x = x + 0.5 * _swiglu(_rmsnorm(x, g_f2), w_g2, w_u2, w_d2)
    x = _rmsnorm(x, g_fin)
    return x, k, v, logf.astype(x.dtype), new_conv


def setup_inputs(seed: int = 0) -> dict:
    key = jax.random.key(seed)
    ks = jax.random.split(key, 32)

    def nrm(k, shape, scale=1.0):
        return jax.random.normal(k, shape, F32) * scale

    def gain(k, n):
        return 1.0 + 0.02 * jax.random.normal(k, (DEPTH, n), F32)

    return {
        'x_prompt': nrm(ks[0], (BATCH, SEQ, D_MODEL)),
        'x_sample': nrm(ks[1], (DEC_BATCH, DEC_SEQ, D_MODEL)),
        'cache_fox_k': nrm(ks[2], (DEPTH, DEC_BATCH, PAST_LEN, FOX_HEADS, HEAD_DIM)),
        'cache_fox_v': nrm(ks[3], (DEPTH, DEC_BATCH, PAST_LEN, FOX_HEADS, HEAD_DIM)),
        'cache_fox_logf': jax.nn.log_sigmoid(2.0 + nrm(ks[4], (DEPTH, DEC_BATCH, PAST_LEN, FOX_HEADS), 0.5)),
        'state_conv': nrm(ks[5], (DEPTH, DEC_BATCH, CONV_K - 1, CONV_DIM)),
        'cache_mem_k': nrm(ks[6], (DEPTH, DEC_BATCH, N_MEM, MEM_HEADS, HEAD_DIM)),
        'cache_mem_v': nrm(ks[7], (DEPTH, DEC_BATCH, N_MEM, MEM_HEADS, HEAD_DIM)),
        'mem_prompt': nrm(ks[8], (BATCH, N_MEM, D_MODEL)),
        'norm_ffn1': gain(ks[9], D_MODEL),
        'w_ffn1_gate': nrm(ks[10], (DEPTH, D_MODEL, D_FF), D_MODEL ** -0.5),
        'w_ffn1_up': nrm(ks[11], (DEPTH, D_MODEL, D_FF), D_MODEL ** -0.5),
        'w_ffn1_down': nrm(ks[12], (DEPTH, D_FF, D_MODEL), D_FF ** -0.5),
        'norm_mix': gain(ks[13], D_MODEL),
        'w_in': nrm(ks[14], (DEPTH, D_MODEL, IN_COLS), D_MODEL ** -0.5),
        'b_forget': 2.0 + nrm(ks[15], (DEPTH, FOX_HEADS), 0.5),
        'conv_w': nrm(ks[16], (DEPTH, CONV_K, CONV_DIM), CONV_K ** -0.5),
        'conv_b': nrm(ks[17], (DEPTH, CONV_DIM), 0.02),
        'q_norm_fox': gain(ks[18], HEAD_DIM),
        'k_norm_fox': gain(ks[19], HEAD_DIM),
        'q_norm_mem': gain(ks[20], HEAD_DIM),
        'k_norm_mem': gain(ks[21], HEAD_DIM),
        'norm_mem': gain(ks[22], D_MODEL),
        'w_mem_kv': nrm(ks[23], (DEPTH, D_MODEL, 2 * MEM_DIM), D_MODEL ** -0.5),
        'w_out': nrm(ks[24], (DEPTH, MIX_DIM, D_MODEL), MIX_DIM ** -0.5),
        'norm_ffn2': gain(ks[25], D_MODEL),
        'w_ffn2_gate': nrm(ks[26], (DEPTH, D_MODEL, D_FF), D_MODEL ** -0.5),
        'w_ffn2_up': nrm(ks[27], (DEPTH, D_MODEL, D_FF), D_MODEL ** -0.5),
        'w_ffn2_down': nrm(ks[28], (DEPTH, D_FF, D_MODEL), D_FF ** -0.5),
        'norm_final': gain(ks[29], D_MODEL),
    }


def reference(x_prompt, x_sample, cache_fox_k, cache_fox_v, cache_fox_logf, state_conv,
              cache_mem_k, cache_mem_v, mem_prompt,
              norm_ffn1, w_ffn1_gate, w_ffn1_up, w_ffn1_down, norm_mix, w_in, b_forget,
              conv_w, conv_b, q_norm_fox, k_norm_fox, q_norm_mem, k_norm_mem, norm_mem,
              w_mem_kv, w_out, norm_ffn2, w_ffn2_gate, w_ffn2_up, w_ffn2_down, norm_final):
    yp, ys = x_prompt, x_sample
    bp = x_prompt.shape[0]
    kp_l, vp_l, fp_l, cp_l, mkp_l, mvp_l = [], [], [], [], [], []
    ks_l, vs_l, fs_l, cs_l = [], [], [], []
    for l in range(DEPTH):
        lp = (norm_ffn1[l], w_ffn1_gate[l], w_ffn1_up[l], w_ffn1_down[l], norm_mix[l], w_in[l],
              b_forget[l], conv_w[l], conv_b[l], q_norm_fox[l], k_norm_fox[l], q_norm_mem[l],
              w_out[l], norm_ffn2[l], w_ffn2_gate[l], w_ffn2_up[l], w_ffn2_down[l], norm_final[l])
        mk_p, mv_p = _mem_kv(mem_prompt, norm_mem[l], w_mem_kv[l], k_norm_mem[l])
        zero_conv = jnp.zeros((bp, CONV_K - 1, CONV_DIM), yp.dtype)
        zero_kv = jnp.zeros((bp, 0, FOX_HEADS, HEAD_DIM), yp.dtype)
        zero_f = jnp.zeros((bp, 0, FOX_HEADS), F32)
        yp, k_p, v_p, f_p, c_p = _layer(yp, zero_conv, zero_kv, zero_kv, zero_f, mk_p, mv_p, lp)
        ys, k_s, v_s, f_s, c_s = _layer(ys, state_conv[l], cache_fox_k[l], cache_fox_v[l],
                                         cache_fox_logf[l], cache_mem_k[l], cache_mem_v[l], lp)
        kp_l.append(k_p); vp_l.append(v_p); fp_l.append(f_p); cp_l.append(c_p)
        mkp_l.append(mk_p); mvp_l.append(mv_p)
        ks_l.append(k_s); vs_l.append(v_s); fs_l.append(f_s); cs_l.append(c_s)
    return (yp, ys,
            jnp.stack(kp_l), jnp.stack(vp_l), jnp.stack(fp_l), jnp.stack(cp_l),
            jnp.stack(mkp_l), jnp.stack(mvp_l),
            jnp.stack(ks_l), jnp.stack(vs_l), jnp.stack(fs_l), jnp.stack(cs_l))
```

```cpp
#include <hip/hip_runtime.h>
#include <cstdio>
#include <cstdint>
__device__ __forceinline__ int lane_of_wave() { return (int)__builtin_amdgcn_mbcnt_hi(~0u, __builtin_amdgcn_mbcnt_lo(~0u, 0u)); }
namespace pg8 {
#define PG8_LAS __attribute__((address_space(3)))
typedef unsigned short bf16_t;
typedef short bf16x8 __attribute__((ext_vector_type(8)));
typedef float f32x4 __attribute__((ext_vector_type(4)));
typedef unsigned u32x4 __attribute__((ext_vector_type(4)));
constexpr int BM = 256, BK = 64, HALF = 128, HTB = HALF * BK * 2  , STAGE_BYTES = 8 * HTB, NXCD = 8, WGM = 8;

__host__ __device__ __forceinline__ int lds_byte(int r, int c) { const int st = (r >> 4) * 2 + (c >> 5), rr = r & 15, cc = c & 31, ob = rr * 64 + cc * 2; return st * 1024 + (ob ^ (((ob >> 9) & 1) << 5)); }
__host__ __device__ __forceinline__ void stage_rc(int b, int& R, int& C) { const int st = b / 1024, sb = b % 1024, swz = sb ^ (((sb >> 9) & 1) << 5); R = (st >> 1) * 16 + swz / 64; C = (st & 1) * 32 + (swz % 64) / 2; }
__host__ __device__ __forceinline__ int perm32(int rho) { const int n = rho >> 4, i = rho & 15; return 8 * (i >> 2) + 4 * n + (i & 3); }

struct Unit { int pm, pn; };
struct Gemm { const bf16_t* A; const bf16_t* Bt; int M, N, K; };

struct StaticOrder {
    int nM, nN, nwg, G, c;
    __host__ __device__ void init(int M, int N, int G_, int c_) { nM = M / BM; nN = N / BM; nwg = nM * nN; G = G_; c = c_; }
    __host__ __device__ bool next(int i, Unit& u) const {
        const long L = (long)i * G + c; if (L >= nwg) return false;
        int wgid = (int)L; { const int q = nwg / NXCD, r = nwg % NXCD, xcd = wgid % NXCD, off = wgid / NXCD; wgid = (xcd < r ? xcd * (q + 1) : r * (q + 1) + (xcd - r) * q) + off; }
        const int nig = WGM * nN, gid = wgid / nig, fm = gid * WGM, gsz = (nM - fm) < WGM ? (nM - fm) : WGM;
        u.pm = fm + ((wgid % nig) % gsz); u.pn = (wgid % nig) / gsz; return true;
    }
    __device__ __forceinline__ void a_ready(const Unit&) const {}
    __device__ __forceinline__ void done(const Unit&) const {}
};
__device__ __forceinline__ unsigned cvt_pk_bf16(float lo, float hi) { unsigned r; asm volatile("v_cvt_pk_bf16_f32 %0, %1, %2" : "=v"(r) : "v"(lo), "v"(hi)); return r; }
typedef float f32x2 __attribute__((ext_vector_type(2)));
template <class Epi, class Sched, bool ALIGN_EPI = false, bool SP2 = false>
__device__ __forceinline__ void gemm_phase(PG8_LAS unsigned char* lds, const Gemm g, const Sched& S, const Epi& E, const int wid_) {
    int wid = wid_, lane = lane_of_wave(); asm volatile("" : "+s"(wid), "+v"(lane));
    const int tid = wid * 64 + lane, wr = wid >> 2, wc = wid & 3, fr = lane & 15, fq = lane >> 4;
    const int K = g.K, nt = K / BK;
    unsigned voffA[2], voffB[2];
#pragma unroll
    for (int i = 0; i < 2; ++i) { int R, C; stage_rc(tid * 16 + i * 8192, R, C); const int Rb = Epi::PERM ? ((R & ~31) + perm32(R & 31)) : R;
        voffA[i] = (unsigned)(R * K + C) * 2u; voffB[i] = (unsigned)(Rb * K + C) * 2u; }
    const size_t kstep = (size_t)(BK * 2);
    const size_t hstep = (size_t)HALF * K * 2;
    const size_t tstep = 2 * hstep;
    const unsigned ldsw = (unsigned)wid * 1024u;
    const int aoff = lds_byte(wr * 64 + fr, fq * 8), boff = lds_byte(wc * 32 + fr, fq * 8);
#define PG8_SA(b, h) (((b) * 2 + (h)) * HTB)
#define PG8_SB(b, h) ((4 + (b) * 2 + (h)) * HTB)
#define PG8_STAGE(bufoff, gbase, voff) do { _Pragma("unroll") for (int _i = 0; _i < 2; ++_i) \
        __builtin_amdgcn_global_load_lds((const unsigned*)((const char*)(gbase) + (voff)[_i]), (PG8_LAS unsigned*)(lds + (bufoff) + ldsw + _i * 8192), 16, 0, 0); } while (0)
#define PG8_LDA(dst, b, h) do { _Pragma("unroll") for (int m = 0; m < 4; ++m) _Pragma("unroll") for (int k = 0; k < 2; ++k) dst[m][k] = *(const PG8_LAS bf16x8*)(lds + PG8_SA(b, h) + aoff + m * 2048 + k * 1024); } while (0)
#define PG8_LDB(dst, b, h) do { _Pragma("unroll") for (int n = 0; n < 2; ++n) _Pragma("unroll") for (int k = 0; k < 2; ++k) dst[n][k] = *(const PG8_LAS bf16x8*)(lds + PG8_SB(b, h) + boff + n * 2048 + k * 1024); } while (0)
#define PG8_MMA(ai, bj, At, Bt) do { __builtin_amdgcn_s_setprio(1); _Pragma("unroll") for (int m = 0; m < 4; ++m) _Pragma("unroll") for (int n = 0; n < 2; ++n) _Pragma("unroll") for (int k = 0; k < 2; ++k) \
        acc[ai][bj][m][n] = __builtin_amdgcn_mfma_f32_16x16x32_bf16(Bt[n][k], At[m][k], acc[ai][bj][m][n], 0, 0, 0); __builtin_amdgcn_s_setprio(0); } while (0)
#define PG8_WAIT_V(n) asm volatile("s_waitcnt vmcnt(" #n ")" ::: "memory")
#define PG8_WAIT_L(n) asm volatile("s_waitcnt lgkmcnt(" #n ")" ::: "memory")
#define PG8_BAR __builtin_amdgcn_s_barrier()
#define PG8_SCHED __builtin_amdgcn_sched_barrier(0)
    Unit cur, nxt; int ui = 0;
    if (!S.next(0, cur)) return;
    f32x4 acc[2][2][4][2];
#pragma unroll
    for (int a = 0; a < 2; ++a)
#pragma unroll
        for (int b = 0; b < 2; ++b)
#pragma unroll
            for (int m = 0; m < 4; ++m)
#pragma unroll
                for (int n = 0; n < 2; ++n) acc[a][b][m][n] = (f32x4){0.f, 0.f, 0.f, 0.f};
    bf16x8 At[4][2], B0[2][2], B1[2][2];
    const char* cA = (const char*)g.A + (size_t)cur.pm * tstep; const char* cB = (const char*)g.Bt + (size_t)cur.pn * tstep;
    S.a_ready(cur);
    if constexpr (SP2) {
        PG8_STAGE(PG8_SB(0, 0), cB, voffB); PG8_STAGE(PG8_SB(0, 1), cB + hstep, voffB); PG8_STAGE(PG8_SA(0, 0), cA, voffA); PG8_STAGE(PG8_SA(0, 1), cA + hstep, voffA);
        if (wr == 1) PG8_BAR;
        PG8_WAIT_V(2); PG8_BAR;
        PG8_STAGE(PG8_SB(1, 0), cB + kstep, voffB); PG8_STAGE(PG8_SA(1, 0), cA + kstep, voffA); PG8_STAGE(PG8_SB(1, 1), cB + hstep + kstep, voffB);
        PG8_WAIT_V(6); PG8_BAR;
    } else {
        PG8_STAGE(PG8_SB(0, 0), cB, voffB); PG8_STAGE(PG8_SA(0, 0), cA, voffA); PG8_STAGE(PG8_SB(0, 1), cB + hstep, voffB); PG8_STAGE(PG8_SA(0, 1), cA + hstep, voffA);
        if (wr == 1) PG8_BAR;
        PG8_WAIT_V(4); PG8_BAR;
        PG8_STAGE(PG8_SB(1, 0), cB + kstep, voffB); PG8_STAGE(PG8_SA(1, 0), cA + kstep, voffA); PG8_STAGE(PG8_SB(1, 1), cB + hstep + kstep, voffB);
        PG8_WAIT_V(6); PG8_BAR;
    }
    for (;;) {
        const bool has_next = S.next(ui + 1, nxt);
        const char* nA = has_next ? (const char*)g.A + (size_t)nxt.pm * tstep : cA; const char* nB = has_next ? (const char*)g.Bt + (size_t)nxt.pn * tstep : cB;
        for (int t = 0; t < nt; t += 2) {
            const bool last = (t == nt - 2);
            const char* a1 = cA + (size_t)(t + 1) * kstep;
            const char* a2 = last ? nA : cA + (size_t)(t + 2) * kstep; const char* b2 = last ? nB : cB + (size_t)(t + 2) * kstep;
            const char* a3 = a2 + kstep; const char* b3 = b2 + kstep;
            if (last && has_next) S.a_ready(nxt);
            if constexpr (SP2) {
            PG8_LDB(B0, 0, 0); PG8_LDB(B1, 0, 1); PG8_SCHED; PG8_LDA(At, 0, 0); PG8_STAGE(PG8_SA(1, 1), a1 + hstep, voffA);
            PG8_WAIT_V(8); PG8_WAIT_L(0); PG8_BAR; PG8_MMA(0, 0, At, B0); PG8_MMA(0, 1, At, B1); PG8_BAR; PG8_SCHED;
            PG8_LDA(At, 0, 1); PG8_STAGE(PG8_SB(0, 0), b2, voffB); PG8_STAGE(PG8_SB(0, 1), b2 + hstep, voffB); PG8_STAGE(PG8_SA(0, 0), a2, voffA);
            PG8_WAIT_V(8); PG8_WAIT_L(0); PG8_BAR; PG8_MMA(1, 0, At, B0); PG8_MMA(1, 1, At, B1); PG8_BAR; PG8_SCHED;
            PG8_LDB(B0, 1, 0); PG8_LDB(B1, 1, 1); PG8_SCHED; PG8_LDA(At, 1, 0); PG8_STAGE(PG8_SA(0, 1), a2 + hstep, voffA);
            PG8_WAIT_V(8); PG8_WAIT_L(0); PG8_BAR; PG8_MMA(0, 0, At, B0); PG8_MMA(0, 1, At, B1); PG8_BAR; PG8_SCHED;
            PG8_LDA(At, 1, 1); PG8_STAGE(PG8_SB(1, 0), b3, voffB); PG8_STAGE(PG8_SB(1, 1), b3 + hstep, voffB); PG8_STAGE(PG8_SA(1, 0), a3, voffA);
            PG8_WAIT_V(8); PG8_WAIT_L(0); PG8_BAR; PG8_MMA(1, 0, At, B0); PG8_MMA(1, 1, At, B1); PG8_BAR; PG8_SCHED;
            } else {
            PG8_LDB(B0, 0, 0); PG8_SCHED; PG8_LDA(At, 0, 0); PG8_STAGE(PG8_SA(1, 1), a1 + hstep, voffA);
            PG8_WAIT_L(8); PG8_BAR; PG8_WAIT_L(0); PG8_MMA(0, 0, At, B0); PG8_BAR; PG8_SCHED;
            PG8_LDB(B1, 0, 1); PG8_STAGE(PG8_SB(0, 0), b2, voffB);
            PG8_BAR; PG8_WAIT_L(0); PG8_MMA(0, 1, At, B1); PG8_BAR;
            PG8_LDA(At, 0, 1); PG8_STAGE(PG8_SA(0, 0), a2, voffA);
            PG8_BAR; PG8_WAIT_L(0); PG8_MMA(1, 0, At, B0); PG8_BAR; PG8_SCHED;
            PG8_STAGE(PG8_SB(0, 1), b2 + hstep, voffB);
            PG8_WAIT_V(6); PG8_BAR; PG8_MMA(1, 1, At, B1); PG8_BAR;
            PG8_LDB(B0, 1, 0); PG8_SCHED; PG8_LDA(At, 1, 0); PG8_STAGE(PG8_SA(0, 1), a2 + hstep, voffA);
            PG8_WAIT_L(8); PG8_BAR; PG8_WAIT_L(0); PG8_MMA(0, 0, At, B0); PG8_BAR; PG8_SCHED;
            PG8_LDB(B1, 1, 1); PG8_STAGE(PG8_SB(1, 0), b3, voffB);
            PG8_BAR; PG8_WAIT_L(0); PG8_MMA(0, 1, At, B1); PG8_BAR;
            PG8_LDA(At, 1, 1); PG8_STAGE(PG8_SA(1, 0), a3, voffA);
            PG8_BAR; PG8_WAIT_L(0); PG8_MMA(1, 0, At, B0); PG8_BAR; PG8_SCHED;
            PG8_STAGE(PG8_SB(1, 1), b3 + hstep, voffB);
            PG8_WAIT_V(6); PG8_BAR; PG8_MMA(1, 1, At, B1); PG8_BAR;
            }
        }
        if constexpr (ALIGN_EPI) { if (wr == 0) PG8_BAR; }
        if constexpr (!Epi::AFTER_DRAIN) { E(acc, cur, wr, wc, fr, fq); S.done(cur); }
        if (!has_next) break;
#pragma unroll
        for (int a = 0; a < 2; ++a)
#pragma unroll
            for (int b = 0; b < 2; ++b)
#pragma unroll
                for (int m = 0; m < 4; ++m)
#pragma unroll
                    for (int n = 0; n < 2; ++n) acc[a][b][m][n] = (f32x4){0.f, 0.f, 0.f, 0.f};
        cur = nxt; cA = nA; cB = nB; ++ui;
        if constexpr (ALIGN_EPI) { if (wr == 1) PG8_BAR; }
    }
    PG8_WAIT_V(0);
    if constexpr (!ALIGN_EPI) { if (wr == 0) PG8_BAR; }
    PG8_BAR;
    if constexpr (Epi::AFTER_DRAIN) { E.fused(acc, cur, wr, wc, fr, fq, lds, wid, lane); S.done(cur); }
#undef PG8_SA
#undef PG8_SB
#undef PG8_STAGE
#undef PG8_LDA
#undef PG8_LDB
#undef PG8_MMA
#undef PG8_WAIT_V
#undef PG8_WAIT_L
#undef PG8_BAR
#undef PG8_SCHED
}
}

constexpr int NWAVES = 8;
#ifndef MK_N_LAUNCHES
#define MK_N_LAUNCHES 1
#endif
constexpr int PER_PHASE = 10;
constexpr int N_LAUNCHES = MK_N_LAUNCHES;
static_assert(N_LAUNCHES == 1 || N_LAUNCHES == PER_PHASE, "MK_N_LAUNCHES is 1 or PER_PHASE");

constexpr int DMODEL = 1024, NB = 2, SEQ = 8192, DB = 32, DS = 32, PAST = 1024, NMEM = 256;
constexpr int MP = NB * SEQ;
constexpr int MS = DB * DS;
constexpr int M = MP + MS;
constexpr int DFF = 2816, NGU = 2 * DFF, NIN = 2816  , INCOLS = 2568;
constexpr int FOXH = 8, MEMH = 4, CONVD = 256;
constexpr int MMEM = NB * NMEM;
constexpr int FSP = 1088;
constexpr float EPSF = 1e-6f;
constexpr size_t O_Y = 0;
constexpr size_t O_FKP = (size_t)M * 1024;
constexpr size_t O_FVP = O_FKP + (size_t)MP * 512;
constexpr size_t O_LFP = O_FVP + (size_t)MP * 512;
constexpr size_t O_CSP = O_LFP + (size_t)MP * 8;
constexpr size_t O_MKP = O_CSP + (size_t)NB * 2 * 256;
constexpr size_t O_MVP = O_MKP + (size_t)MMEM * 256;
constexpr size_t O_FKS = O_MVP + (size_t)MMEM * 256;
constexpr size_t O_FVS = O_FKS + (size_t)MS * 512;
constexpr size_t O_LFS = O_FVS + (size_t)MS * 512;
constexpr size_t O_CSS = O_LFS + (size_t)MS * 8;
constexpr size_t O_END = O_CSS + (size_t)DB * 2 * 256;
static_assert(O_END == 36070400, "d_out layout");

constexpr size_t MiB = 1u << 20;
constexpr size_t WS_CTL = 0, CTL_ZERO_BYTES = 1 * MiB;
constexpr size_t WS_WGU1 = 2 * MiB, WS_WD1 = 13 * MiB, WS_WIN = 19 * MiB, WS_WOUT = 25 * MiB, WS_WGU2 = 27 * MiB, WS_WD2 = 38 * MiB, WS_WMKV = 44 * MiB;
constexpr size_t WS_MEMB = 45 * MiB;
constexpr size_t WS_MK = 46 * MiB, WS_MV = WS_MK + 256 * 1024;
constexpr size_t WS_FP2 = 47 * MiB;
constexpr size_t WS_FS2 = WS_FP2 + 512 * 1024;
constexpr size_t WS_SS1 = 50 * MiB;
constexpr size_t WS_PAR = 51 * MiB;
constexpr int PAR_GQF = 0, PAR_GKF = 64, PAR_GQM = 128, PAR_GKM = 192, PAR_BF = 256, PAR_CW = 512, PAR_CB = 1280, PAR_GFIN = 2048, PAR_N = 3072;
constexpr size_t WS_XB = 52 * MiB;
constexpr size_t WS_BIG = 86 * MiB;
constexpr size_t WS_ACT = WS_BIG;
constexpr size_t WS_Q = WS_BIG, WS_K = WS_Q + 17 * MiB, WS_V = WS_K + 17 * MiB, WS_QM = WS_V + 17 * MiB, WS_CI = WS_QM + 9 * MiB, WS_BG = WS_CI + 17 * MiB, WS_MIX = WS_BG + 9 * MiB;
constexpr size_t WS_END = WS_MIX + 34 * MiB;
static_assert(WS_ACT + (size_t)M * DFF * 2 <= 256 * MiB && WS_END <= 256 * MiB, "d_ws map fits 256 MiB");
static_assert((size_t)M * 512 * 2 <= 17 * MiB && (size_t)M * 256 * 2 <= 9 * MiB && (size_t)M * 256 * 4 <= 17 * MiB && (size_t)M * 1024 * 2 <= 34 * MiB, "d_ws map pieces");
static_assert(WS_FS2 + (size_t)DB * FOXH * FSP * 4 <= WS_SS1 && WS_SS1 + (size_t)M * 4 <= WS_XB && WS_XB + (size_t)M * 1024 * 2 <= WS_BIG, "d_ws map small pieces");
constexpr int CW_TMO = 0, CW_CODE = 1;
constexpr int CW_BAR = 4096;
constexpr int CW_SS2 = 65536, CW_SS3 = CW_SS2 + 32768, CW_SS4 = CW_SS3 + 32768;
static_assert((CW_SS4 + 32768) * 4 <= (int)CTL_ZERO_BYTES && M <= 32768, "CTL words inside the memset region");

constexpr int RING_OFF = 0, RING_BYTES = 131072;
constexpr int LDSCTL_OFF = RING_BYTES, MISC_OFF = LDSCTL_OFF + 320;
constexpr int SAUX_OFF = RING_BYTES + 1024;
constexpr int LDS_BYTES = 147456;
static_assert(MISC_OFF + 128 <= SAUX_OFF && SAUX_OFF + 4096 <= LDS_BYTES, "LDS map");


namespace pg8 {
constexpr float RMS_EPS = 1e-6f;
constexpr float LOG2E = 1.4426950408889634f;
constexpr float QSCALE = 0.125f * 1.4426950408889634f;
typedef unsigned u32x2 __attribute__((ext_vector_type(2)));
__device__ __forceinline__ float rs_of(const float* ss, int row) { return 1.0f / sqrtf(ss[row] * (1.0f / 1024.0f) + RMS_EPS); }
__device__ __forceinline__ u32x4 pack8(const f32x4 a, const f32x4 b) { u32x4 w; w.x = cvt_pk_bf16(a[0], a[1]); w.y = cvt_pk_bf16(a[2], a[3]); w.z = cvt_pk_bf16(b[0], b[1]); w.w = cvt_pk_bf16(b[2], b[3]); return w; }

struct EpiSwiGLU {
    static constexpr bool PERM = true, AFTER_DRAIN = false;
    bf16_t* O; const float* ss;
    __device__ __forceinline__ void operator()(const f32x4 (&acc)[2][2][4][2], const Unit& u, int wr, int wc, int fr, int fq) const {
        const int row0 = u.pm * BM + wr * 64 + fr, col0 = u.pn * 128 + wc * 32 + 8 * fq;
#pragma unroll
        for (int ai = 0; ai < 2; ++ai)
#pragma unroll
            for (int m = 0; m < 4; ++m) {
                const int row = row0 + ai * HALF + m * 16; const float rs = rs_of(ss, row);
                f32x4 o[2];
#pragma unroll
                for (int n = 0; n < 2; ++n)
#pragma unroll
                    for (int j = 0; j < 4; ++j) { const float g = acc[ai][0][m][n][j] * rs, up = acc[ai][1][m][n][j] * rs;
                        const float e = __builtin_amdgcn_exp2f(-LOG2E * g); o[n][j] = g * __builtin_amdgcn_rcpf(1.0f + e) * up; }
                *(u32x4*)(O + (size_t)row * 2816 + col0) = pack8(o[0], o[1]);
            }
    }
};

struct EpiResid {
    static constexpr bool PERM = true, AFTER_DRAIN = false;
    const float* base0; const float* base1; float* X; bf16_t* XB; float* ss; float alpha;
    __device__ __forceinline__ void operator()(const f32x4 (&acc)[2][2][4][2], const Unit& u, int wr, int wc, int fr, int fq) const {
        const int row0 = u.pm * BM + wr * 64 + fr, col0 = u.pn * BM + wc * 32 + 8 * fq;
        const float* bp0 = (u.pm < 64) ? base0 + (size_t)row0 * 1024 : base1 + (size_t)(row0 - 16384) * 1024;
#pragma unroll
        for (int ai = 0; ai < 2; ++ai)
#pragma unroll
            for (int m = 0; m < 4; ++m) {
                const int row = row0 + ai * HALF + m * 16; const size_t ro = (size_t)(ai * HALF + m * 16) * 1024; float sq = 0.f;
#pragma unroll
                for (int bj = 0; bj < 2; ++bj) {
                    const float* bp = bp0 + ro + col0 + bj * HALF;
                    const f32x4 b0 = *(const f32x4*)bp, b1 = *(const f32x4*)(bp + 4);
                    const f32x4 x0 = b0 + acc[ai][bj][m][0] * alpha, x1 = b1 + acc[ai][bj][m][1] * alpha;
                    float* xp = X + (size_t)row * 1024 + col0 + bj * HALF; *(f32x4*)xp = x0; *(f32x4*)(xp + 4) = x1;
                    if (XB) *(u32x4*)(XB + (size_t)row * 1024 + col0 + bj * HALF) = pack8(x0, x1);
                    sq += (x0[0] * x0[0] + x0[1] * x0[1]) + (x0[2] * x0[2] + x0[3] * x0[3]) + (x1[0] * x1[0] + x1[1] * x1[1]) + (x1[2] * x1[2] + x1[3] * x1[3]);
                }
                sq += __shfl_xor(sq, 16); sq += __shfl_xor(sq, 32);
                if (fq == 0) unsafeAtomicAdd(ss + row, sq);
            }
    }
};

template <bool NORM> __device__ __forceinline__ void epi_heads(const f32x4 (&acc)[2][2][4][2], int row0, int rloc0, const float* ss, const float* gain, float scale,
                                                               bf16_t* ob, int obp, float* of, int ofp, int hcol, int fq) {
    f32x4 gv[2][2];
#pragma unroll
    for (int bj = 0; bj < 2; ++bj)
#pragma unroll
        for (int n = 0; n < 2; ++n) gv[bj][n] = NORM ? *(const f32x4*)(gain + 32 * bj + 8 * fq + 4 * n) * scale : (f32x4){scale, scale, scale, scale};
#pragma unroll
    for (int ai = 0; ai < 2; ++ai)
#pragma unroll
        for (int m = 0; m < 4; ++m) {
            const int dr = ai * HALF + m * 16; const float rs = ss ? rs_of(ss, row0 + dr) : 1.0f;
            f32x4 v[2][2]; float sq = 0.f;
#pragma unroll
            for (int bj = 0; bj < 2; ++bj)
#pragma unroll
                for (int n = 0; n < 2; ++n) { v[bj][n] = acc[ai][bj][m][n] * rs; const f32x4 t = v[bj][n]; sq += (t[0] * t[0] + t[1] * t[1]) + (t[2] * t[2] + t[3] * t[3]); }
            float hr = 1.0f;
            if (NORM) { sq += __shfl_xor(sq, 16); sq += __shfl_xor(sq, 32); hr = 1.0f / sqrtf(sq * (1.0f / 64.0f) + RMS_EPS); }
#pragma unroll
            for (int bj = 0; bj < 2; ++bj) {
                const f32x4 a = v[bj][0] * hr * gv[bj][0], b = v[bj][1] * hr * gv[bj][1];
                *(u32x4*)(ob + (size_t)(row0 + dr) * obp + hcol + 32 * bj + 8 * fq) = pack8(a, b);
                if (of) { float* fp = of + (size_t)(rloc0 + dr) * ofp + hcol + 32 * bj + 8 * fq; *(f32x4*)fp = a; *(f32x4*)(fp + 4) = b; }
            }
        }
}

struct EpiWin {
    static constexpr bool PERM = true, AFTER_DRAIN = false;
    unsigned char* ws; float* out;
    __device__ __forceinline__ void operator()(const f32x4 (&acc)[2][2][4][2], const Unit& u, int wr, int wc, int fr, int fq) const {
        const float* ss = (const float*)(ws + WS_CTL) + CW_SS2; const float* par = (const float*)(ws + WS_PAR);
        const int pn = u.pn, row0 = u.pm * BM + wr * 64 + fr; const bool samp = u.pm >= 64; const int rloc0 = row0 - (samp ? 16384 : 0);
        if (pn < 2) epi_heads<true>(acc, row0, rloc0, ss, par + PAR_GQF, QSCALE, (bf16_t*)(ws + WS_Q), 512, nullptr, 0, (pn * 4 + wc) * 64, fq);
        else if (pn < 4) epi_heads<true>(acc, row0, rloc0, ss, par + PAR_GKF, 1.0f, (bf16_t*)(ws + WS_K), 512, out + (samp ? O_FKS : O_FKP), 512, ((pn - 2) * 4 + wc) * 64, fq);
        else if (pn < 6) epi_heads<false>(acc, row0, rloc0, ss, nullptr, 1.0f, (bf16_t*)(ws + WS_V), 512, out + (samp ? O_FVS : O_FVP), 512, ((pn - 4) * 4 + wc) * 64, fq);
        else if (pn == 6) epi_heads<true>(acc, row0, rloc0, ss, par + PAR_GQM, QSCALE, (bf16_t*)(ws + WS_QM), 256, nullptr, 0, wc * 64, fq);
        else if (pn < 9) {
            float* CI = (float*)(ws + WS_CI);
            const int col0 = (pn - 7) * 128 + wc * 32 + 8 * fq;
#pragma unroll
            for (int ai = 0; ai < 2; ++ai)
#pragma unroll
                for (int m = 0; m < 4; ++m) { const int row = row0 + ai * HALF + m * 16; const float rs = rs_of(ss, row), r2 = rs * rs;
                    float* cp = CI + (size_t)row * 256 + col0;
                    *(f32x4*)cp = acc[ai][0][m][0] * acc[ai][1][m][0] * r2; *(f32x4*)(cp + 4) = acc[ai][0][m][1] * acc[ai][1][m][1] * r2; }
        } else if (pn == 9) {
            bf16_t* BG = (bf16_t*)(ws + WS_BG);
#pragma unroll
            for (int ai = 0; ai < 2; ++ai)
#pragma unroll
                for (int m = 0; m < 4; ++m) { const int row = row0 + ai * HALF + m * 16; const float rs = rs_of(ss, row);
#pragma unroll
                    for (int bj = 0; bj < 2; ++bj) *(u32x4*)(BG + (size_t)row * 256 + bj * HALF + wc * 32 + 8 * fq) = pack8(acc[ai][bj][m][0] * rs, acc[ai][bj][m][1] * rs); }
        } else {
            if (wc == 0 && fq == 0) {
                float* lf = out + (samp ? O_LFS : O_LFP); const float* bf = par + PAR_BF;
#pragma unroll
                for (int ai = 0; ai < 2; ++ai)
#pragma unroll
                    for (int m = 0; m < 4; ++m) { const int dr = ai * HALF + m * 16; const float rs = rs_of(ss, row0 + dr); f32x4 o[2];
#pragma unroll
                        for (int n = 0; n < 2; ++n)
#pragma unroll
                            for (int j = 0; j < 4; ++j) { const float z = acc[ai][0][m][n][j] * rs + bf[4 * n + j]; o[n][j] = fminf(z, 0.f) - log1pf(expf(-fabsf(z))); }
                        float* p = lf + (size_t)(rloc0 + dr) * 8; *(f32x4*)p = o[0]; *(f32x4*)(p + 4) = o[1]; }
            }
        }
    }
};

struct EpiMemKV {
    static constexpr bool PERM = true, AFTER_DRAIN = false;
    unsigned char* ws; float* out;
    __device__ __forceinline__ void operator()(const f32x4 (&acc)[2][2][4][2], const Unit& u, int wr, int wc, int fr, int fq) const {
        const int row0 = u.pm * BM + wr * 64 + fr;
        if (u.pn == 0) epi_heads<true>(acc, row0, row0, nullptr, (const float*)(ws + WS_PAR) + PAR_GKM, 1.0f, (bf16_t*)(ws + WS_MK), 256, out + O_MKP, 256, wc * 64, fq);
        else epi_heads<false>(acc, row0, row0, nullptr, nullptr, 1.0f, (bf16_t*)(ws + WS_MV), 256, out + O_MVP, 256, wc * 64, fq);
    }
};
}

#include <hip/hip_bf16.h>
#include <cmath>
namespace attn_body {
using bf16=__hip_bfloat16;
using bf16x8=__attribute__((ext_vector_type(8)))short;
using s16x4=__attribute__((ext_vector_type(4)))short;
using f32x16=__attribute__((ext_vector_type(16)))float;
using u32x4=__attribute__((ext_vector_type(4)))unsigned;
constexpr int D=64;
constexpr int NW=8,QBLK=32,QB=QBLK*NW,KVBLK=64;
__device__ __forceinline__ int crow(int r,int hi){return (r&3)+8*(r>>2)+4*hi;}
#define SBAR() __builtin_amdgcn_sched_barrier(0)
__device__ __forceinline__ void cmask(f32x16&p0,f32x16&p1,int jb,int qrel,int hi){
  const float NEG=-INFINITY; int kb=64*jb+4*hi;
  #pragma unroll
  for(int r=0;r<16;++r){int kv=kb+(r&3)+8*(r>>2); if(kv>qrel)p0[r]=NEG; if(kv+32>qrel)p1[r]=NEG;}
}
constexpr int NSLOT=3, SLOTB=8192;
constexpr int LDS_K=0, LDS_V=NSLOT*SLOTB, LDS_WS=2*NSLOT*SLOTB, LDS_OST=LDS_WS+NW*64*4, LDS_TAB=LDS_OST+NW*4096, TAB_BYTES=8192*4, LDS_BYTES=LDS_TAB+TAB_BYTES;
constexpr float C2=0.125f*1.4426950408889634f;
__device__ __forceinline__ void glds16(const void*gsrc,unsigned lds_dst){unsigned keep;
  asm volatile("s_mov_b32 %0, m0\n\ts_mov_b32 m0, %2\n\ts_nop 0\n\tglobal_load_lds_dwordx4 %1, off\n\ts_mov_b32 m0, %0":"=&s"(keep):"v"(gsrc),"s"(lds_dst):"memory");}
__device__ __forceinline__ float max3f(float a,float b,float c){float r;asm("v_max3_f32 %0, %1, %2, %3":"=v"(r):"v"(a),"v"(b),"v"(c));return r;}
__device__ __forceinline__ float max2f(float a,float b){float r;asm("v_max_f32_e32 %0, %1, %2":"=v"(r):"v"(a),"v"(b));return r;}
__device__ __forceinline__ float fadd_s(float a,float b){float r;asm("v_add_f32_e32 %0, %1, %2":"=v"(r):"v"(a),"v"(b));return r;}
__device__ __forceinline__ float fsub_s(float a,float b){float r;asm("v_sub_f32_e32 %0, %1, %2":"=v"(r):"v"(a),"v"(b));return r;}
typedef float f32x2_t __attribute__((ext_vector_type(2))); typedef __bf16 bf16x2_t __attribute__((ext_vector_type(2)));
__device__ __forceinline__ unsigned cvtpk_s(float lo,float hi){f32x2_t v={lo,hi};bf16x2_t b=__builtin_convertvector(v,bf16x2_t);return __builtin_bit_cast(unsigned,b);}
#define WAIT_BAR(N) asm volatile("s_waitcnt vmcnt(" #N ") lgkmcnt(0)\n\ts_barrier":::"memory")

__device__ __forceinline__ void qkt(f32x16&p0,f32x16&p1,const char*Kslot,const bf16x8*qr,int r32,int hi){
  const char*kb=Kslot+hi*1024+r32*16;
  #pragma unroll
  for(int d0=0;d0<4;++d0){
    const bf16x8 b0=*reinterpret_cast<const bf16x8*>(kb+d0*2048);
    const bf16x8 b1=*reinterpret_cast<const bf16x8*>(kb+d0*2048+512);
    p0=__builtin_amdgcn_mfma_f32_32x32x16_bf16(b0,qr[d0],p0,0,0,0);p1=__builtin_amdgcn_mfma_f32_32x32x16_bf16(b1,qr[d0],p1,0,0,0);}
}
typedef __attribute__((address_space(3))) const char* lds_cptr;
typedef short v4i16_t __attribute__((ext_vector_type(4)));
__device__ __forceinline__ void kload8(bf16x8*kf,lds_cptr kp){
  kf[0]=*(const __attribute__((address_space(3))) bf16x8*)(kp);      kf[1]=*(const __attribute__((address_space(3))) bf16x8*)(kp+512);
  kf[2]=*(const __attribute__((address_space(3))) bf16x8*)(kp+2048); kf[3]=*(const __attribute__((address_space(3))) bf16x8*)(kp+2560);
  kf[4]=*(const __attribute__((address_space(3))) bf16x8*)(kp+4096); kf[5]=*(const __attribute__((address_space(3))) bf16x8*)(kp+4608);
  kf[6]=*(const __attribute__((address_space(3))) bf16x8*)(kp+6144); kf[7]=*(const __attribute__((address_space(3))) bf16x8*)(kp+6656);
}
__device__ __forceinline__ void kload2(bf16x8*kf,lds_cptr kp,int j){ kf[2*j]=*(const __attribute__((address_space(3))) bf16x8*)(kp+j*2048); kf[2*j+1]=*(const __attribute__((address_space(3))) bf16x8*)(kp+j*2048+512); }
__device__ __forceinline__ s16x4 vtr(lds_cptr p){ return __builtin_bit_cast(s16x4,__builtin_amdgcn_ds_read_tr16_b64_v4i16((__attribute__((address_space(3))) v4i16_t*)p)); }
__device__ __forceinline__ float rowmax(const f32x16&p0,const f32x16&p1){
  float a=max3f(p0[0],p0[1],p1[0]),b=max3f(p0[2],p0[3],p1[1]);a=max3f(a,p1[2],p1[3]);
  #pragma unroll
  for(int r=4;r<16;r+=4){a=max3f(a,p0[r],p0[r+1]);b=max3f(b,p0[r+2],p0[r+3]);a=max3f(a,p1[r],p1[r+1]);b=max3f(b,p1[r+2],p1[r+3]);}
  const float m=max2f(a,b);
  auto rr=__builtin_amdgcn_permlane32_swap(__float_as_uint(m),__float_as_uint(m),false,false);
  return max2f(__uint_as_float(rr[0]),__uint_as_float(rr[1]));
}
__device__ __forceinline__ void pv(f32x16*o,int vb,bf16x8 pa0,bf16x8 pa1,bf16x8 pa2,bf16x8 pa3){
  #pragma unroll
  for(int d0=0;d0<2;++d0){s16x4 lo[4],hi[4];
    #pragma unroll
    for(int ks=0;ks<4;++ks){
      asm volatile("ds_read_b64_tr_b16 %0,%1 offset:%c2":"=&v"(lo[ks]):"v"(vb),"i"(d0*4096+ks*1024):"memory");
      asm volatile("ds_read_b64_tr_b16 %0,%1 offset:%c2":"=&v"(hi[ks]):"v"(vb),"i"(d0*4096+ks*1024+512):"memory");}
    asm volatile("s_waitcnt lgkmcnt(0)":::"memory");SBAR();
    #define PK(k) (bf16x8){lo[k][0],lo[k][1],lo[k][2],lo[k][3],hi[k][0],hi[k][1],hi[k][2],hi[k][3]}
    o[d0]=__builtin_amdgcn_mfma_f32_32x32x16_bf16(pa0,PK(0),o[d0],0,0,0);
    o[d0]=__builtin_amdgcn_mfma_f32_32x32x16_bf16(pa1,PK(1),o[d0],0,0,0);
    o[d0]=__builtin_amdgcn_mfma_f32_32x32x16_bf16(pa2,PK(2),o[d0],0,0,0);
    o[d0]=__builtin_amdgcn_mfma_f32_32x32x16_bf16(pa3,PK(3),o[d0],0,0,0);
    #undef PK
  }
}

#ifndef ATTN_STORE16
#define ATTN_STORE16(p,v) (*(u32x4*)(p)=(v))
#endif
template<int THRL,bool CAUSAL,bool BIAS,int QP,int KP,int OP> __device__ __forceinline__ void attn_unit(const bf16*Qu,const bf16*__restrict__ Kh,const bf16*__restrict__ Vh,bf16*Ou,int NT,const float*F2,int s0,int q0abs,char*shm,const int wid_){
  int wid=wid_,lane=lane_of_wave(); asm volatile("":"+s"(wid),"+v"(lane)); const int tid=wid*64+lane,r32=lane&31,hi=lane>>5;
  const bf16*Qw=Qu+(long)wid*QBLK*QP;
  const unsigned lds0=(unsigned)(uintptr_t)shm;
  float*wsf=(float*)(shm+LDS_WS)+wid*64;
  const bf16*ksrc=Kh+(long)lane*KP+wid*8;
  const bf16*vsrc=Vh+(long)(16*(wid&3)+(lane>>2))*KP+(wid>>2)*32+(lane&3)*8;
  const unsigned kdst=lds0+LDS_K+wid*1024, vdst=lds0+LDS_V+wid*1024;
  #define DMA_K(t,slot) glds16(ksrc+(long)(t)*KVBLK*KP,(unsigned)__builtin_amdgcn_readfirstlane(kdst+(slot)))
  #define DMA_V(t,slot) glds16(vsrc+(long)(t)*KVBLK*KP,(unsigned)__builtin_amdgcn_readfirstlane(vdst+(slot)))
  const int vb0=(int)(lds0+LDS_V)+((lane>>4)&1)*32+(lane&3)*8+(4*hi+((lane&15)>>2))*64;
  const char*Kbase=shm+LDS_K; bf16x8 kf[8];
  const lds_cptr shm3=(lds_cptr)shm; const lds_cptr kp0=shm3+LDS_K+hi*1024+r32*16; const lds_cptr vp0=shm3+LDS_V+((lane>>4)&1)*32+(lane&3)*8+(4*hi+((lane&15)>>2))*64;
  typedef __attribute__((address_space(3))) float lds_f32; typedef float f32x4_t __attribute__((ext_vector_type(4)));
  lds_f32*tab=(lds_f32*)(shm3+LDS_TAB);
  if(BIAS){ const float fref=F2[q0abs]; for(int s=tid;s<NT*KVBLK;s+=NW*64)tab[s]=fref-F2[s0+s]; }
  DMA_K(0,0);DMA_V(0,0);DMA_K(1,SLOTB);
  bf16x8 qr[4];
  #pragma unroll
  for(int d0=0;d0<4;++d0)qr[d0]=*reinterpret_cast<const bf16x8*>(&Qw[(long)r32*QP+d0*16+hi*8]);
  float mhat=0.f,l_reg=0.f;f32x16 o[2];o[0]=f32x16{};o[1]=f32x16{};
  #define CINIT(C0,C1,t) do{ if(BIAS){ const __attribute__((address_space(3))) f32x4_t*tp_=(const __attribute__((address_space(3))) f32x4_t*)(tab+(t)*KVBLK+4*hi); \
      _Pragma("unroll") for(int g_=0;g_<4;++g_){ const f32x4_t a_=tp_[2*g_], b_=tp_[2*g_+8]; \
        _Pragma("unroll") for(int i_=0;i_<4;++i_){ C0[4*g_+i_]=a_[i_]-mhat; C1[4*g_+i_]=b_[i_]-mhat; } } } \
    else { _Pragma("unroll") for(int r_=0;r_<16;++r_){ C0[r_]=-mhat; C1[r_]=-mhat; } } }while(0)
  const int qrel=wid*QBLK+r32;
  #define CMASK(P0,P1,t) do{int jb_=(t)-(NT-4); if(CAUSAL&&jb_>=0)cmask(P0,P1,jb_,qrel,hi);}while(0)
  bool resc=false;
  #define START(P0,P1) do{ const float rm=rowmax(P0,P1); resc=false; \
    { const float dl=rm; mhat=fadd_s(mhat,dl); \
      _Pragma("unroll") for(int r=0;r<16;++r){P0[r]=fsub_s(P0[r],dl);P1[r]=fsub_s(P1[r],dl);} \
      } \
    _Pragma("unroll") for(int r=0;r<16;++r)P0[r]=__builtin_amdgcn_exp2f(P0[r]); }while(0)
  #define RESC() do{ if(resc){ asm volatile("s_waitcnt lgkmcnt(0)":::"memory"); \
      _Pragma("unroll") for(int d_=0;d_<2;++d_) _Pragma("unroll") for(int r=0;r<16;++r)o[d_][r]*=wsf[crow(r,hi)]; } }while(0)
  f32x16 pA0,pA1,pB0,pB1;
  int sl_prev=0,sl_cur=0,sl_next=SLOTB;
  #define ROT() do{sl_prev=sl_cur;sl_cur=sl_next;sl_next=(sl_next==(NSLOT-1)*SLOTB)?0:sl_next+SLOTB;}while(0)
  DMA_K(2,2*SLOTB);
  WAIT_BAR(3);
  CINIT(pA0,pA1,0); qkt(pA0,pA1,Kbase,qr,r32,hi);asm volatile("s_nop 15\n\ts_nop 7":"+v"(pA0),"+v"(pA1));CMASK(pA0,pA1,0);
  START(pA0,pA1);
  _Pragma("unroll") for(int r=0;r<16;++r)pA1[r]=__builtin_amdgcn_exp2f(pA1[r]);
  WAIT_BAR(0);
  DMA_K(3,0);DMA_V(1,SLOTB);
  ROT();
  kload8(kf,kp0+sl_cur);
  WAIT_BAR(2);
  s16x4 vlo[8],vhi[8]; u32x4 pw0,pw1,pw2,pw3;
  #define PKW(P,B) cvtpk_s(P[B],P[B+1])
  #define PAF(k) __builtin_bit_cast(bf16x8,pw##k)
  #define VFR(i) (bf16x8){vlo[i][0],vlo[i][1],vlo[i][2],vlo[i][3],vhi[i][0],vhi[i][1],vhi[i][2],vhi[i][3]}
  #define PIN(x) asm volatile("":"+v"(x))
  #define MX3(a,b,c) __builtin_fmaxf(__builtin_fmaxf((a),(b)),(c))
  #define GAPA(MF,A0,A1,A2,A3,W0,W1,PW) do{ MF; sacc+=A0; sacc+=A1; sacc+=A2; sacc+=A3; PIN(sacc); W0; W1; PIN(PW); SBAR(); }while(0)
  #define EX(v) __builtin_amdgcn_exp2f(v)
  #define GAPB(MF,X,B) do{ MF; X[B]=EX(X[B]); X[B+1]=EX(X[B+1]); X[B+2]=EX(X[B+2]); X[B+3]=EX(X[B+3]); PIN(X); SBAR(); }while(0)
  #define VRD(i) do{ vlo[i]=vtr(vp_+(((i)>>2)*4096+((i)&3)*1024)); vhi[i]=vtr(vp_+(((i)>>2)*4096+((i)&3)*1024+512)); }while(0)
  #define KRD(G,j) do{ if(G){ kload2(kf,kp0+sl_next,j); SBAR(); } }while(0)
  #define STEP(C0,C1,P0,P1,t,GK,GV,GL) do{ CINIT(C0,C1,t); SBAR(); \
    const lds_cptr vp_=vp0+sl_prev; \
    VRD(0); SBAR(); float sacc=(P0[0]+P0[1]); \
    GAPA(C0=__builtin_amdgcn_mfma_f32_32x32x16_bf16(kf[0],qr[0],C0,0,0,0), P0[2],P0[3],P0[4],P0[5],     pw0[0]=PKW(P0,0), pw0[1]=PKW(P0,2), pw0); \
    VRD(4); SBAR(); GAPA(C1=__builtin_amdgcn_mfma_f32_32x32x16_bf16(kf[1],qr[0],C1,0,0,0), P0[6],P0[7],P0[8],P0[9],     pw0[2]=PKW(P0,4), pw0[3]=PKW(P0,6), pw0); \
    VRD(1); SBAR(); GAPA(C0=__builtin_amdgcn_mfma_f32_32x32x16_bf16(kf[2],qr[1],C0,0,0,0),   P0[10],P0[11],P0[12],P0[13], pw1[0]=PKW(P0,8), pw1[1]=PKW(P0,10), pw1); \
    VRD(5); SBAR(); GAPA(C1=__builtin_amdgcn_mfma_f32_32x32x16_bf16(kf[3],qr[1],C1,0,0,0),   P0[14],P0[15],P1[0],P1[1],   pw1[2]=PKW(P0,12),pw1[3]=PKW(P0,14), pw1); \
    VRD(2); SBAR(); GAPA(C0=__builtin_amdgcn_mfma_f32_32x32x16_bf16(kf[4],qr[2],C0,0,0,0),   P1[2],P1[3],P1[4],P1[5],     pw2[0]=PKW(P1,0), pw2[1]=PKW(P1,2), pw2); \
    VRD(6); SBAR(); GAPA(C1=__builtin_amdgcn_mfma_f32_32x32x16_bf16(kf[5],qr[2],C1,0,0,0),   P1[6],P1[7],P1[8],P1[9],     pw2[2]=PKW(P1,4), pw2[3]=PKW(P1,6), pw2); \
    VRD(3); SBAR(); GAPA(C0=__builtin_amdgcn_mfma_f32_32x32x16_bf16(kf[6],qr[3],C0,0,0,0),   P1[10],P1[11],P1[12],P1[13], pw3[0]=PKW(P1,8), pw3[1]=PKW(P1,10), pw3); \
    VRD(7); SBAR(); GAPA(C1=__builtin_amdgcn_mfma_f32_32x32x16_bf16(kf[7],qr[3],C1,0,0,0),   P1[14],P1[15],0.f,0.f,       pw3[2]=PKW(P1,12),pw3[3]=PKW(P1,14), pw3); \
    l_reg+=sacc; \
    if(GK){DMA_K((t)+3,sl_cur);} if(GV){DMA_V((t)+1,sl_next);} \
    CMASK(C0,C1,t); \
    { float a=MX3(C0[0],C0[1],C1[0]),b=MX3(C0[2],C0[3],C1[1]); a=MX3(a,C1[2],C1[3]); \
      _Pragma("unroll") for(int r=4;r<16;r+=4){a=MX3(a,C0[r],C0[r+1]);b=MX3(b,C0[r+2],C0[r+3]);a=MX3(a,C1[r],C1[r+1]);b=MX3(b,C1[r+2],C1[r+3]);} \
      float rm=__builtin_fmaxf(a,b); { auto rr=__builtin_amdgcn_permlane32_swap(__float_as_uint(rm),__float_as_uint(rm),false,false); rm=__builtin_fmaxf(__uint_as_float(rr[0]),__uint_as_float(rr[1])); } \
      resc=false; \
      if(__builtin_expect(__any(rm>(float)THRL),0)){ const float dl=__builtin_fmaxf(rm,0.f); mhat+=dl; \
        _Pragma("unroll") for(int r=0;r<16;++r){C0[r]-=dl;C1[r]-=dl;} \
        const float f=__builtin_amdgcn_exp2f(-dl); l_reg*=f; if(hi==0)wsf[r32]=f; resc=true; } } \
    SBAR(); \
    GAPB(o[0]=__builtin_amdgcn_mfma_f32_32x32x16_bf16(PAF(0),VFR(0),o[0],0,0,0), C0,0); \
    GAPB(o[1]=__builtin_amdgcn_mfma_f32_32x32x16_bf16(PAF(0),VFR(4),o[1],0,0,0), C0,4); \
    KRD(GL,0); GAPB(o[0]=__builtin_amdgcn_mfma_f32_32x32x16_bf16(PAF(1),VFR(1),o[0],0,0,0), C0,8); \
    KRD(GL,1); GAPB(o[1]=__builtin_amdgcn_mfma_f32_32x32x16_bf16(PAF(1),VFR(5),o[1],0,0,0), C0,12); \
    KRD(GL,2); GAPB(o[0]=__builtin_amdgcn_mfma_f32_32x32x16_bf16(PAF(2),VFR(2),o[0],0,0,0), C1,0); \
    KRD(GL,3); GAPB(o[1]=__builtin_amdgcn_mfma_f32_32x32x16_bf16(PAF(2),VFR(6),o[1],0,0,0), C1,4); \
    GAPB(o[0]=__builtin_amdgcn_mfma_f32_32x32x16_bf16(PAF(3),VFR(3),o[0],0,0,0), C1,8); \
    GAPB(o[1]=__builtin_amdgcn_mfma_f32_32x32x16_bf16(PAF(3),VFR(7),o[1],0,0,0), C1,12); \
    }while(0)
  int t=1;
  #undef CMASK
  #define CMASK(P0,P1,t) do{}while(0)
  for(;t+5<NT;t+=2){
    STEP(pB0,pB1,pA0,pA1,t,true,true,true);     WAIT_BAR(2); RESC(); ROT();
    STEP(pA0,pA1,pB0,pB1,t+1,true,true,true);   WAIT_BAR(2); RESC(); ROT();
  }
  #undef CMASK
  #define CMASK(P0,P1,t) do{int jb_=(t)-(NT-4); if(CAUSAL&&jb_>=0)cmask(P0,P1,jb_,qrel,hi);}while(0)
  #define ENDW(tt) do{ if((tt)+3<NT){WAIT_BAR(2);} else if((tt)+2<NT){WAIT_BAR(1);} else {WAIT_BAR(0);} }while(0)
  for(;t+1<NT;t+=2){
    STEP(pB0,pB1,pA0,pA1,t,(t+3<NT),(t+1<NT),(t+1<NT));       ENDW(t);   RESC(); ROT();
    STEP(pA0,pA1,pB0,pB1,t+1,(t+4<NT),(t+2<NT),(t+2<NT));     ENDW(t+1); RESC(); ROT();
  }
  STEP(pB0,pB1,pA0,pA1,NT-1,false,false,false); RESC();
  { float sacc=pB0[0]+pB0[1]; _Pragma("unroll") for(int r=2;r<16;++r)sacc+=pB0[r]; _Pragma("unroll") for(int r=0;r<16;++r)sacc+=pB1[r]; l_reg+=sacc;
    pw0=(u32x4){PKW(pB0,0),PKW(pB0,2),PKW(pB0,4),PKW(pB0,6)};pw1=(u32x4){PKW(pB0,8),PKW(pB0,10),PKW(pB0,12),PKW(pB0,14)};pw2=(u32x4){PKW(pB1,0),PKW(pB1,2),PKW(pB1,4),PKW(pB1,6)};pw3=(u32x4){PKW(pB1,8),PKW(pB1,10),PKW(pB1,12),PKW(pB1,14)};
    SBAR(); pv(o,vb0+sl_cur,PAF(0),PAF(1),PAF(2),PAF(3)); }
  #undef PKW
  #undef PAF
  #undef VFR
  #undef PIN
  #undef MX3
  #undef GAPA
  #undef GAPB
  #undef EX
  #undef VRD
  #undef KRD
  #undef STEP
  #undef ENDW
  {auto rr=__builtin_amdgcn_permlane32_swap(__float_as_uint(l_reg),__float_as_uint(l_reg),false,false);l_reg=__uint_as_float(rr[0])+__uint_as_float(rr[1]);}
  if(hi==0)wsf[32+r32]=l_reg;asm volatile("s_waitcnt lgkmcnt(0)":::"memory");
  float rli[16];
  #pragma unroll
  for(int r=0;r<16;++r)rli[r]=__builtin_amdgcn_rcpf(wsf[32+crow(r,hi)]);
  bf16*Ow=Ou+(long)wid*QBLK*OP;
  { bf16*stg=(bf16*)(shm+LDS_OST)+wid*2048;
    #pragma unroll
    for(int r=0;r<16;++r){const int orow=crow(r,hi);
      #pragma unroll
      for(int d0=0;d0<2;++d0)stg[orow*64+d0*32+r32]=__float2bfloat16(o[d0][r]*rli[r]);}
    asm volatile("s_waitcnt lgkmcnt(0)":::"memory");
    #pragma unroll
    for(int i=0;i<4;++i){const int row=i*8+(lane>>3),ch=lane&7; const u32x4 v=*(const u32x4*)(stg+row*64+ch*8); ATTN_STORE16(Ow+(long)row*OP+ch*8,v);} }
  asm volatile("s_waitcnt lgkmcnt(0)\n\ts_barrier":::"memory");
  #undef CINIT
  #undef DMA_K
  #undef DMA_V
  #undef CMASK
  #undef START
  #undef RESC
  #undef ROT
}

typedef __attribute__((address_space(3))) char* lds_ptr;
typedef float f32x4s __attribute__((ext_vector_type(4)));
__device__ __forceinline__ u32x4 pack8s(const f32x4s a,const f32x4s b){ u32x4 w; w.x=cvtpk_s(a[0],a[1]); w.y=cvtpk_s(a[2],a[3]); w.z=cvtpk_s(b[0],b[1]); w.w=cvtpk_s(b[2],b[3]); return w; }
__device__ __forceinline__ void samp_stage(const float*Ksrc,const float*Vsrc,int rstride,int nvalid,lds_ptr Kslot,lds_ptr Vslot,int lane){
  const int r0=lane>>2,q4=lane&3;
  #pragma unroll
  for(int i=0;i<4;++i){ const int r=r0+16*i;
    f32x4s k0={0.f,0.f,0.f,0.f},k1=k0,k2=k0,k3=k0,v0=k0,v1=k0,v2=k0,v3=k0;
    if(r<nvalid){ const f32x4s*kp=(const f32x4s*)(Ksrc+(size_t)r*rstride+q4*16); const f32x4s*vp=(const f32x4s*)(Vsrc+(size_t)r*rstride+q4*16);
      k0=kp[0];k1=kp[1];k2=kp[2];k3=kp[3]; v0=vp[0];v1=vp[1];v2=vp[2];v3=vp[3]; }
    *(__attribute__((address_space(3))) u32x4*)(Kslot+(2*q4)*1024+r*16)=pack8s(k0,k1);
    *(__attribute__((address_space(3))) u32x4*)(Kslot+(2*q4+1)*1024+r*16)=pack8s(k2,k3);
    *(__attribute__((address_space(3))) u32x4*)(Vslot+(q4>>1)*4096+r*64+(q4&1)*32)=pack8s(v0,v1);
    *(__attribute__((address_space(3))) u32x4*)(Vslot+(q4>>1)*4096+r*64+(q4&1)*32+16)=pack8s(v2,v3);
  }
}
__device__ __forceinline__ float rowmax_c(const f32x16&p0,const f32x16&p1){
  float a=__builtin_fmaxf(p0[0],p1[0]);
  #pragma unroll
  for(int r=1;r<16;++r)a=__builtin_fmaxf(a,__builtin_fmaxf(p0[r],p1[r]));
  auto rr=__builtin_amdgcn_permlane32_swap(__float_as_uint(a),__float_as_uint(a),false,false);
  return __builtin_fmaxf(__uint_as_float(rr[0]),__uint_as_float(rr[1]));
}
struct SampState { float mhat,l; f32x16 o[2]; };
__device__ __forceinline__ void samp_tile(SampState&st,const bf16x8*qr,lds_ptr Kslot,lds_ptr Vslot,const float*bias,float fref,bool causal_new,int nvalid,__attribute__((address_space(3))) float*wsf,int lane){
  const int r32=lane&31,hi=lane>>5;
  f32x16 p0,p1;
  #pragma unroll
  for(int g=0;g<4;++g){ f32x4s a={0.f,0.f,0.f,0.f},b=a;
    if(bias){ a=*(const f32x4s*)(bias+8*g+4*hi); a=fref-a; if(nvalid>32){ b=*(const f32x4s*)(bias+32+8*g+4*hi); b=fref-b; } }
    #pragma unroll
    for(int i=0;i<4;++i){p0[4*g+i]=a[i];p1[4*g+i]=b[i];} }
  { const lds_cptr kb=(lds_cptr)Kslot+hi*1024+r32*16;
    #pragma unroll
    for(int d0=0;d0<4;++d0){
      const bf16x8 b0=*(const __attribute__((address_space(3))) bf16x8*)(kb+d0*2048);
      const bf16x8 b1=*(const __attribute__((address_space(3))) bf16x8*)(kb+d0*2048+512);
      p0=__builtin_amdgcn_mfma_f32_32x32x16_bf16(b0,qr[d0],p0,0,0,0);p1=__builtin_amdgcn_mfma_f32_32x32x16_bf16(b1,qr[d0],p1,0,0,0);} }
  #pragma unroll
  for(int r=0;r<16;++r){ const int kv=crow(r,hi); const bool ok0=(kv<nvalid)&&(!causal_new||kv<=r32), ok1=(kv+32<nvalid)&&(!causal_new||kv+32<=r32);
    if(!ok0)p0[r]=-INFINITY; if(!ok1)p1[r]=-INFINITY; }
  const float rm=rowmax_c(p0,p1), mnew=__builtin_fmaxf(st.mhat,rm), alpha=__builtin_amdgcn_exp2f(st.mhat-mnew);
  float ls=0.f;
  #pragma unroll
  for(int r=0;r<16;++r){ p0[r]=__builtin_amdgcn_exp2f(p0[r]-mnew); p1[r]=__builtin_amdgcn_exp2f(p1[r]-mnew); ls+=p0[r]+p1[r]; }
  st.l=st.l*alpha+ls; st.mhat=mnew;
  if(hi==0)wsf[r32]=alpha;
  asm volatile("s_waitcnt lgkmcnt(0)":::"memory");
  #pragma unroll
  for(int r=0;r<16;++r){ const float a=wsf[crow(r,hi)]; st.o[0][r]*=a; st.o[1][r]*=a; }
  u32x4 pw0,pw1,pw2,pw3;
  pw0=(u32x4){cvtpk_s(p0[0],p0[1]),cvtpk_s(p0[2],p0[3]),cvtpk_s(p0[4],p0[5]),cvtpk_s(p0[6],p0[7])};
  pw1=(u32x4){cvtpk_s(p0[8],p0[9]),cvtpk_s(p0[10],p0[11]),cvtpk_s(p0[12],p0[13]),cvtpk_s(p0[14],p0[15])};
  pw2=(u32x4){cvtpk_s(p1[0],p1[1]),cvtpk_s(p1[2],p1[3]),cvtpk_s(p1[4],p1[5]),cvtpk_s(p1[6],p1[7])};
  pw3=(u32x4){cvtpk_s(p1[8],p1[9]),cvtpk_s(p1[10],p1[11]),cvtpk_s(p1[12],p1[13]),cvtpk_s(p1[14],p1[15])};
  const int vb=(int)(unsigned)(uintptr_t)Vslot+((lane>>4)&1)*32+(lane&3)*8+(4*hi+((lane&15)>>2))*64;
  asm volatile("s_waitcnt lgkmcnt(0)":::"memory"); SBAR();
  pv(st.o,vb,__builtin_bit_cast(bf16x8,pw0),__builtin_bit_cast(bf16x8,pw1),__builtin_bit_cast(bf16x8,pw2),__builtin_bit_cast(bf16x8,pw3));
}
template<class Tiles> __device__ __forceinline__ void samp_unit(const Tiles&T,const bf16*Qu,int QP,bf16*Ou,int OP,char*shm,char*aux,const int wid_){
  int wid=wid_,lane=lane_of_wave(); asm volatile("":"+s"(wid),"+v"(lane)); const int tid=wid*64+lane,r32=lane&31,hi=lane>>5;
  const lds_ptr Kslot=(lds_ptr)shm+wid*16384, Vslot=Kslot+8192;
  __attribute__((address_space(3))) float*wsf=(__attribute__((address_space(3))) float*)((lds_ptr)aux+wid*128);
  __attribute__((address_space(3))) float*ml=(__attribute__((address_space(3))) float*)((lds_ptr)aux+1024);
  bf16x8 qr[4];
  #pragma unroll
  for(int d0=0;d0<4;++d0)qr[d0]=*reinterpret_cast<const bf16x8*>(&Qu[(long)r32*QP+d0*16+hi*8]);
  SampState st; st.mhat=-1e30f; st.l=0.f; st.o[0]=f32x16{}; st.o[1]=f32x16{};
  const int nt=T.ntiles(wid);
  for(int i=0;i<nt;++i){
    const float*ks;const float*vs;int rstride,nvalid;const float*bias;bool cn; T.tile(wid,i,ks,vs,rstride,nvalid,bias,cn);
    samp_stage(ks,vs,rstride,nvalid,Kslot,Vslot,lane);
    asm volatile("s_waitcnt lgkmcnt(0)":::"memory");
    samp_tile(st,qr,Kslot,Vslot,bias,T.fref(),cn,nvalid,wsf,lane);
    asm volatile("s_waitcnt lgkmcnt(0)":::"memory");
  }
  { auto rr=__builtin_amdgcn_permlane32_swap(__float_as_uint(st.l),__float_as_uint(st.l),false,false); st.l=__uint_as_float(rr[0])+__uint_as_float(rr[1]); }
  if(hi==0){ ml[wid*64+r32]=st.mhat; ml[wid*64+32+r32]=st.l; }
  { __attribute__((address_space(3))) float*op=(__attribute__((address_space(3))) float*)Kslot;
    #pragma unroll
    for(int r=0;r<16;++r){ const int q=crow(r,hi); op[q*64+r32]=st.o[0][r]; op[q*64+32+r32]=st.o[1][r]; } }
  asm volatile("s_waitcnt lgkmcnt(0)\n\ts_barrier":::"memory");
  { const int q=tid>>4,d4=(tid&15)*4; float mw[8],M=-3e38f;
    #pragma unroll
    for(int w=0;w<8;++w){ mw[w]=ml[w*64+q]; M=__builtin_fmaxf(M,mw[w]); }
    float L=0.f; f32x4s acc={0.f,0.f,0.f,0.f};
    #pragma unroll
    for(int w=0;w<8;++w){ const float f=__builtin_amdgcn_exp2f(mw[w]-M); L+=f*ml[w*64+32+q];
      const f32x4s ov=*(const __attribute__((address_space(3))) f32x4s*)((lds_ptr)shm+w*16384+(q*64+d4)*4); acc+=ov*f; }
    const float inv=1.0f/L; typedef unsigned u32x2s __attribute__((ext_vector_type(2)));
    u32x2s w2; w2.x=cvtpk_s(acc[0]*inv,acc[1]*inv); w2.y=cvtpk_s(acc[2]*inv,acc[3]*inv);
    *(u32x2s*)(Ou+(long)q*OP+d4)=w2; }
  asm volatile("s_waitcnt lgkmcnt(0)\n\ts_barrier":::"memory");
}
#undef SBAR
#undef WAIT_BAR
}

static_assert(attn_body::LDS_BYTES <= RING_BYTES, "attention LDS fits the ring region");
#define GAS __attribute__((address_space(1)))
#define LAS __attribute__((address_space(3)))
typedef unsigned short bf16;
typedef unsigned v4u __attribute__((ext_vector_type(4)));
typedef float f32x4 __attribute__((ext_vector_type(4)));
typedef short bf16x8 __attribute__((ext_vector_type(8)));
typedef GAS unsigned gu32;
typedef GAS unsigned long long gu64;
#define RLX_AGENT __ATOMIC_RELAXED, __HIP_MEMORY_SCOPE_AGENT
#define LDS_WAIT() asm volatile("s_waitcnt lgkmcnt(0)" ::: "memory")
#define VM_WAIT() asm volatile("s_waitcnt vmcnt(0)" ::: "memory")
__device__ __forceinline__ unsigned long long rt() { return __builtin_amdgcn_s_memrealtime(); }
__device__ __forceinline__ unsigned f2bf(float f) { unsigned u = __builtin_bit_cast(unsigned, f); return (u + 0x7fffu + ((u >> 16) & 1u)) >> 16; }
__device__ __forceinline__ unsigned pk2(float lo, float hi) { return f2bf(lo) | (f2bf(hi) << 16); }


#define XB_TMO      128
#define XB_XCNT(j)  (256  + 64 * (j))
#define XB_XSUB(j)  (1280 + 64 * (j))
#define XB_XGEN(j)  (2304 + 64 * (j))
#define XB_TOP      3328
#define XB_TOPGEN   3392
#define XCD_BAR_WORDS 3456
#define XB_SPIN_CAP (1u << 18)

__device__ __forceinline__ unsigned xb_ld(unsigned* p)              { return __hip_atomic_load(p, __ATOMIC_RELAXED, __HIP_MEMORY_SCOPE_AGENT); }
__device__ __forceinline__ unsigned xb_add(unsigned* p, unsigned v) { return __hip_atomic_fetch_add(p, v, __ATOMIC_RELAXED, __HIP_MEMORY_SCOPE_AGENT); }
__device__ __forceinline__ unsigned xb_xcc_id() { return (unsigned)__builtin_amdgcn_s_getreg((3 << 11) | 20) & 0xFu; }
#define XB_SPIN(cond, bar) do { unsigned _sp = 0; while (cond) { __builtin_amdgcn_s_sleep(1); \
    if ((++_sp & 255u) == 0u) { if (xb_ld(&(bar)[XB_TMO])) break; if (_sp > XB_SPIN_CAP) { atomicAdd(&(bar)[XB_TMO], 1u); break; } } } } while (0)

struct XcdBarrier {
    unsigned* bar; unsigned x; int wv;
    volatile LAS unsigned* st;
};

__device__ __forceinline__ XcdBarrier xcd_barrier_post(unsigned* bar, volatile LAS unsigned* st, int wv) {
    XcdBarrier b; b.bar = bar; b.x = xb_xcc_id(); b.st = st; b.wv = wv;
    if (wv == 0 && lane_of_wave() == 0) (void)xb_add(&bar[XB_XCNT(b.x)], 1u);
    return b;
}
__device__ __forceinline__ void xcd_barrier_complete(unsigned* bar, unsigned x, unsigned& nloc, unsigned& nx) {
    const unsigned G = gridDim.x * gridDim.y * gridDim.z;
    unsigned sum, cnt, mine, sp = 0u;
    for (;;) {
        sum = 0u; cnt = 0u; mine = 0u;
#pragma unroll
        for (unsigned j = 0; j < 16; ++j) { const unsigned c = xb_ld(&bar[XB_XCNT(j)]); sum += c; cnt += (c > 0u) ? 1u : 0u; mine = (j == x) ? c : mine; }
        if (sum == G) break;
        __builtin_amdgcn_s_sleep(1);
        if ((++sp & 255u) == 0u) { if (xb_ld(&bar[XB_TMO])) break; if (sp > XB_SPIN_CAP) { atomicAdd(&bar[XB_TMO], 1u); break; } }
    }
    nloc = mine > 0u ? mine : 1u; nx = cnt > 0u ? cnt : 1u;
}

__device__ __forceinline__ void xcd_barrier(const XcdBarrier& b) {
    asm volatile("s_waitcnt vmcnt(0)" ::: "memory");
    __syncthreads();
    if (b.wv == 0 && lane_of_wave() == 0) {
        unsigned* bar = b.bar;
        __builtin_amdgcn_s_waitcnt(0);
        unsigned nloc = b.st[0], nx = b.st[1];
        if (nloc == 0u) { xcd_barrier_complete(bar, b.x, nloc, nx); b.st[0] = nloc; b.st[1] = nx; }
        const unsigned old = xb_add(&bar[XB_XSUB(b.x)], 1u);
        const unsigned gen = old / nloc;
        if (old + 1u == (gen + 1u) * nloc) {
            __builtin_amdgcn_fence(__ATOMIC_RELEASE, "agent");
            asm volatile("s_waitcnt vmcnt(0)" ::: "memory");
            const unsigned og = xb_add(&bar[XB_TOP], 1u);
            const unsigned tg = og / nx;
            if (og + 1u == (tg + 1u) * nx) xb_add(&bar[XB_TOPGEN], 1u);
            else XB_SPIN(xb_ld(&bar[XB_TOPGEN]) == tg, bar);
            __builtin_amdgcn_fence(__ATOMIC_ACQUIRE, "agent");
            xb_add(&bar[XB_XGEN(b.x)], 1u);
            asm volatile("s_waitcnt vmcnt(0)" ::: "memory");
        } else {
            XB_SPIN(xb_ld(&bar[XB_XGEN(b.x)]) == gen, bar);
            __builtin_amdgcn_fence(__ATOMIC_ACQUIRE, "agent");
            asm volatile("s_waitcnt vmcnt(0)" ::: "memory");
        }
    }
    __syncthreads();
}


struct Args { const float* in[30]; float* out; unsigned char* ws; int ph_lo, ph_hi; };
typedef const float* const __attribute__((address_space(4))) * karg_tab_t;
__device__ __forceinline__ const float* karg(int i) { auto p = __builtin_amdgcn_kernarg_segment_ptr(); asm volatile("" : "+s"(p)); return ((karg_tab_t)p)[i]; }
#define KARG(i) karg(i)
static_assert(sizeof(Args) == 32 * 8 + 8, "Args has no padding");
enum InIdx { I_XP = 0, I_XS, I_CFK, I_CFV, I_CFLF, I_SCONV, I_CMK, I_CMV, I_MEMP, I_NF1, I_WG1, I_WU1, I_WD1, I_NMIX, I_WIN, I_BF, I_CW, I_CB, I_GQF, I_GKF, I_GQM, I_GKM, I_NMEM, I_WMKV, I_WOUT, I_NF2, I_WG2, I_WU2, I_WD2, I_NFIN };

struct Frame {
    LAS unsigned char* lds;
    volatile LAS unsigned* MISC;
    gu32* ctl;
    int wave;
    int vcu, G;
};

#define FLANE lane_of_wave()
#define FTID (F.wave * 64 + lane_of_wave())
__device__ __forceinline__ float wave_sum(float v) {
#pragma unroll
    for (int o = 1; o < 64; o <<= 1) v += __shfl_xor(v, o);
    return v;
}

enum SegKind { SK_IDENT = 0, SK_GATE, SK_UP, SK_WIN_U, SK_WIN_C, SK_WIN_B, SK_HEADS };
__device__ __forceinline__ int dst_row(int kind, int pn0, int e) {
    switch (kind) {
        case SK_GATE:  return 256 * (e >> 7) + (e & 127);
        case SK_UP:    return 256 * (e >> 7) + 128 + (e & 127);
        case SK_WIN_U: return 256 * (7 + (e >> 7)) + (e & 127);
        case SK_WIN_C: return 256 * (7 + (e >> 7)) + 128 + (e & 127);
        case SK_WIN_B: return 256 * 9 + e;
        case SK_HEADS: { const int head = e >> 6, d = e & 63; return 256 * (pn0 + (head >> 2)) + 128 * (d >> 5) + 32 * (head & 3) + (d & 31); }
        default:       return e;
    }
}
__device__ __forceinline__ void p0_transpose_item(const float* W, int ldw, int K, int scol, int ncols, bf16* WT, int kind, int pn0, const float* gain, LAS float* scr, int item, int lane) {
    const int nblk = ncols / 32, kb = item / nblk, nb = item % nblk, k0 = 64 * kb, e0 = 32 * nb;
#pragma unroll 8
    for (int i = 0; i < 32; ++i) { const int kk = 2 * i + (lane >> 5); const float g = gain ? gain[k0 + kk] : 1.0f; scr[kk * 33 + (lane & 31)] = W[(size_t)(k0 + kk) * ldw + scol + e0 + (lane & 31)] * g; }
    LDS_WAIT(); asm volatile("" ::: "memory");
    const int c = lane & 7; const int r0 = dst_row(kind, pn0, e0);
#pragma unroll
    for (int j = 0; j < 4; ++j) { const int n = (lane >> 3) + 8 * j; const LAS float* s = scr + (8 * c) * 33 + n;
        v4u o; o.x = pk2(s[0 * 33], s[1 * 33]); o.y = pk2(s[2 * 33], s[3 * 33]); o.z = pk2(s[4 * 33], s[5 * 33]); o.w = pk2(s[6 * 33], s[7 * 33]);
        *(GAS v4u*)(WT + (size_t)(r0 + n) * K + k0 + 8 * c) = o; }
    LDS_WAIT(); asm volatile("" ::: "memory");
}
template <bool NORMALISE> __device__ __forceinline__ void row_to_bf16(const float* xrow, bf16* orow, float* ssp, int lane) {
    const GAS f32x4* xr = (const GAS f32x4*)xrow + lane;
    f32x4 v[4]; float s = 0.f;
#pragma unroll
    for (int j = 0; j < 4; ++j) { v[j] = xr[64 * j]; s += (v[j].x * v[j].x + v[j].y * v[j].y) + (v[j].z * v[j].z + v[j].w * v[j].w); }
    s = wave_sum(s);
    const float sc = NORMALISE ? 1.0f / sqrtf(s * (1.0f / 1024.0f) + EPSF) : 1.0f;
    GAS unsigned long long* o8 = (GAS unsigned long long*)orow + lane;
#pragma unroll
    for (int j = 0; j < 4; ++j) o8[64 * j] = (unsigned long long)pk2(v[j].x * sc, v[j].y * sc) | ((unsigned long long)pk2(v[j].z * sc, v[j].w * sc) << 32);
    if (ssp && lane == 0) *ssp = s;
}

__device__ __forceinline__ void scan_seq(Frame& F, const float* srcA, int LA, const float* srcB, int L, float* out, int pitch) {
    LAS float* tot = (LAS float*)(F.lds + RING_OFF);
    const int R = (L + 511) / 512, s0 = FTID * R;
    float a[8];
#pragma unroll
    for (int h = 0; h < 8; ++h) a[h] = 0.f;
    for (int i = 0; i < R; ++i) { const int s = s0 + i; if (s < L) { const float* p = (s < LA) ? srcA + (size_t)8 * s : srcB + (size_t)8 * (s - LA);
            const f32x4 x = *(const f32x4*)p, y = *(const f32x4*)(p + 4); a[0] += x.x; a[1] += x.y; a[2] += x.z; a[3] += x.w; a[4] += y.x; a[5] += y.y; a[6] += y.z; a[7] += y.w; } }
#pragma unroll
    for (int h = 0; h < 8; ++h) tot[FTID * 8 + h] = a[h];
    __syncthreads();
    {
        const int h = F.wave; float v[8], run = 0.f;
#pragma unroll
        for (int k = 0; k < 8; ++k) { v[k] = tot[(FLANE * 8 + k) * 8 + h]; run += v[k]; }
        float inc = run;
#pragma unroll
        for (int o = 1; o < 64; o <<= 1) { const float t = __shfl_up(inc, o); if (FLANE >= o) inc += t; }
        float pre = inc - run;
#pragma unroll
        for (int k = 0; k < 8; ++k) { tot[(FLANE * 8 + k) * 8 + h] = pre; pre += v[k]; }
    }
    __syncthreads();
#pragma unroll
    for (int h = 0; h < 8; ++h) a[h] = tot[FTID * 8 + h];
    for (int i = 0; i < R; ++i) { const int s = s0 + i; if (s < L) { const float* p = (s < LA) ? srcA + (size_t)8 * s : srcB + (size_t)8 * (s - LA);
            const f32x4 x = *(const f32x4*)p, y = *(const f32x4*)(p + 4); a[0] += x.x; a[1] += x.y; a[2] += x.z; a[3] += x.w; a[4] += y.x; a[5] += y.y; a[6] += y.z; a[7] += y.w;
#pragma unroll
            for (int h = 0; h < 8; ++h) out[(size_t)h * pitch + s] = a[h] * 1.4426950408889634f; } }
    __syncthreads();
}

__global__ void __launch_bounds__(NWAVES * 64, 2) hybrid_fwd(Args args) {
    extern __shared__ __attribute__((aligned(16))) unsigned char lds[];
    Frame F;
    F.lds = (LAS unsigned char*)lds;
    F.MISC = (volatile LAS unsigned*)(F.lds + MISC_OFF);
    F.wave = __builtin_amdgcn_readfirstlane((int)threadIdx.x >> 6);
    F.G = gridDim.x; { const int bx = blockIdx.x; F.vcu = (F.G % 8 == 0) ? (bx % 8) * (F.G / 8) + bx / 8 : bx; }
    unsigned char* ws = args.ws; float* out = args.out;
    F.ctl = (gu32*)(ws + WS_CTL);
    bf16* Wgu1 = (bf16*)(ws + WS_WGU1); bf16* Wd1 = (bf16*)(ws + WS_WD1); bf16* Win = (bf16*)(ws + WS_WIN); bf16* Wout = (bf16*)(ws + WS_WOUT);
    bf16* Wgu2 = (bf16*)(ws + WS_WGU2); bf16* Wd2 = (bf16*)(ws + WS_WD2); bf16* Wmkv = (bf16*)(ws + WS_WMKV);
    bf16* MEMB = (bf16*)(ws + WS_MEMB); bf16* MKb = (bf16*)(ws + WS_MK); bf16* MVb = (bf16*)(ws + WS_MV);
    float* FP2 = (float*)(ws + WS_FP2); float* FS2 = (float*)(ws + WS_FS2); float* SS1 = (float*)(ws + WS_SS1);
    float* SS2 = (float*)(ws + WS_CTL) + CW_SS2; float* SS3 = (float*)(ws + WS_CTL) + CW_SS3; float* SS4 = (float*)(ws + WS_CTL) + CW_SS4;
    bf16* XB = (bf16*)(ws + WS_XB); bf16* ACT = (bf16*)(ws + WS_ACT);
    bf16* Qb = (bf16*)(ws + WS_Q); bf16* Kb = (bf16*)(ws + WS_K); bf16* Vb = (bf16*)(ws + WS_V); bf16* QMb = (bf16*)(ws + WS_QM);
    float* CI = (float*)(ws + WS_CI); bf16* BG = (bf16*)(ws + WS_BG); bf16* MIX = (bf16*)(ws + WS_MIX);
    float* X = out + O_Y;
    for (int u = FTID; u < (LDS_BYTES - LDSCTL_OFF) / 4; u += NWAVES * 64) ((LAS unsigned*)(F.lds + LDSCTL_OFF))[u] = 0u;
    __syncthreads();
    XcdBarrier bar; bar.bar = (unsigned*)(F.ctl + CW_BAR); bar.x = 0; bar.st = nullptr; bar.wv = F.wave;
    if (N_LAUNCHES == 1) bar = xcd_barrier_post((unsigned*)(F.ctl + CW_BAR), F.MISC + 8, F.wave);
#define GRID_BAR(seam) do { if (N_LAUNCHES == PER_PHASE) { if (FTID == 0) __hip_atomic_store(F.ctl + CW_TMO, 0xBADBA0u | (unsigned)(seam), RLX_AGENT); } else { xcd_barrier(bar); } } while (0)
    const int lo = args.ph_lo, hi = args.ph_hi;
#define IN(k) (lo <= (k) && (k) < hi)
#define BOTH(k) (IN(k) && IN((k) + 1))
    const int gw = F.vcu * NWAVES + F.wave, NGW = F.G * NWAVES;

    if (IN(0)) {
        LAS float* scr = (LAS float*)(F.lds + RING_OFF + F.wave * 16384);
        constexpr int I_GU = 16 * 88, I_DN = 44 * 32, I_W256 = 16 * 8, I_W512 = 16 * 16, I_WO = 16 * 32;
        constexpr int NITEMS = 3 * I_GU + 3 * I_W256 + 3 * I_W512 + I_W256 + I_WO + 3 * I_GU + 2 * I_W256;
        static_assert(I_GU == I_DN, "items");
        for (int it = gw; it < NITEMS; it += NGW) {
            int r = it;
            if (r < I_GU) { p0_transpose_item(KARG(I_WG1), DFF, 1024, 0, DFF, Wgu1, SK_GATE, 0, KARG(I_NF1), scr, r, FLANE); continue; } r -= I_GU;
            if (r < I_GU) { p0_transpose_item(KARG(I_WU1), DFF, 1024, 0, DFF, Wgu1, SK_UP, 0, KARG(I_NF1), scr, r, FLANE); continue; } r -= I_GU;
            if (r < I_DN) { p0_transpose_item(KARG(I_WD1), 1024, DFF, 0, 1024, Wd1, SK_IDENT, 0, nullptr, scr, r, FLANE); continue; } r -= I_DN;
            if (r < I_W256) { p0_transpose_item(KARG(I_WIN), INCOLS, 1024, 0, 256, Win, SK_WIN_U, 0, KARG(I_NMIX), scr, r, FLANE); continue; } r -= I_W256;
            if (r < I_W256) { p0_transpose_item(KARG(I_WIN), INCOLS, 1024, 256, 256, Win, SK_WIN_C, 0, KARG(I_NMIX), scr, r, FLANE); continue; } r -= I_W256;
            if (r < I_W256) { p0_transpose_item(KARG(I_WIN), INCOLS, 1024, 512, 256, Win, SK_WIN_B, 0, KARG(I_NMIX), scr, r, FLANE); continue; } r -= I_W256;
            if (r < I_W512) { p0_transpose_item(KARG(I_WIN), INCOLS, 1024, 768, 512, Win, SK_HEADS, 0, KARG(I_NMIX), scr, r, FLANE); continue; } r -= I_W512;
            if (r < I_W512) { p0_transpose_item(KARG(I_WIN), INCOLS, 1024, 1280, 512, Win, SK_HEADS, 2, KARG(I_NMIX), scr, r, FLANE); continue; } r -= I_W512;
            if (r < I_W512) { p0_transpose_item(KARG(I_WIN), INCOLS, 1024, 1792, 512, Win, SK_HEADS, 4, KARG(I_NMIX), scr, r, FLANE); continue; } r -= I_W512;
            if (r < I_W256) { p0_transpose_item(KARG(I_WIN), INCOLS, 1024, 2312, 256, Win, SK_HEADS, 6, KARG(I_NMIX), scr, r, FLANE); continue; } r -= I_W256;
            if (r < I_WO) { p0_transpose_item(KARG(I_WOUT), 1024, 1024, 0, 1024, Wout, SK_IDENT, 0, nullptr, scr, r, FLANE); continue; } r -= I_WO;
            if (r < I_GU) { p0_transpose_item(KARG(I_WG2), DFF, 1024, 0, DFF, Wgu2, SK_GATE, 0, KARG(I_NF2), scr, r, FLANE); continue; } r -= I_GU;
            if (r < I_GU) { p0_transpose_item(KARG(I_WU2), DFF, 1024, 0, DFF, Wgu2, SK_UP, 0, KARG(I_NF2), scr, r, FLANE); continue; } r -= I_GU;
            if (r < I_DN) { p0_transpose_item(KARG(I_WD2), 1024, DFF, 0, 1024, Wd2, SK_IDENT, 0, nullptr, scr, r, FLANE); continue; } r -= I_DN;
            if (r < I_W256) { p0_transpose_item(KARG(I_WMKV), 512, 1024, 0, 256, Wmkv, SK_HEADS, 0, KARG(I_NMEM), scr, r, FLANE); continue; } r -= I_W256;
            p0_transpose_item(KARG(I_WMKV), 512, 1024, 256, 256, Wmkv, SK_HEADS, 1, KARG(I_NMEM), scr, r, FLANE);
        }
        for (int i = blockIdx.x * (NWAVES * 64) + FTID; i < 256 * 1024 / 2; i += F.G * NWAVES * 64) {
            const int rr = (2 * i) >> 10, k = (2 * i) & 1023; unsigned w = 0u;
            if (rr < 8) { const float* wi = KARG(I_WIN); const float* g = KARG(I_NMIX); w = pk2(wi[(size_t)k * INCOLS + 2304 + rr] * g[k], wi[(size_t)(k + 1) * INCOLS + 2304 + rr] * g[k + 1]); }
            *(unsigned*)(Win + (size_t)(2560 + rr) * 1024 + k) = w;
        }
        if (blockIdx.x == 0) {
            float* par = (float*)(ws + WS_PAR);
            for (int i = FTID; i < PAR_N; i += NWAVES * 64) { float v = 0.f;
                if (i < 64) v = KARG(I_GQF)[i]; else if (i < 128) v = KARG(I_GKF)[i - 64]; else if (i < 192) v = KARG(I_GQM)[i - 128]; else if (i < 256) v = KARG(I_GKM)[i - 192];
                else if (i < 264) v = KARG(I_BF)[i - 256]; else if (i >= PAR_CW && i < PAR_CW + 768) v = KARG(I_CW)[i - PAR_CW]; else if (i >= PAR_CB && i < PAR_CB + 256) v = KARG(I_CB)[i - PAR_CB];
                else if (i >= PAR_GFIN) v = KARG(I_NFIN)[i - PAR_GFIN];
                par[i] = v; }
        }
        for (int m = gw; m < M; m += NGW) row_to_bf16<false>(m < MP ? KARG(I_XP) + (size_t)m * 1024 : KARG(I_XS) + (size_t)(m - MP) * 1024, XB + (size_t)m * 1024, SS1 + m, FLANE);
        for (int m = gw; m < MMEM; m += NGW) row_to_bf16<true>(KARG(I_MEMP) + (size_t)m * 1024, MEMB + (size_t)m * 1024, nullptr, FLANE);
        if (BOTH(0)) GRID_BAR(0);
    }

    if (IN(1)) {
        { pg8::Gemm g{XB, Wgu1, M, NGU, 1024}; pg8::StaticOrder S; S.init(M, NGU, F.G, (int)blockIdx.x);
          pg8::EpiSwiGLU E{ACT, SS1};
          pg8::gemm_phase<pg8::EpiSwiGLU, pg8::StaticOrder, true, true>(F.lds + RING_OFF, g, S, E, F.wave); }
        { pg8::Gemm g{MEMB, Wmkv, MMEM, 512, 1024}; pg8::StaticOrder S; S.init(MMEM, 512, F.G, (int)((blockIdx.x + F.G - 216) % F.G));
          pg8::EpiMemKV E{ws, out};
          pg8::gemm_phase<pg8::EpiMemKV, pg8::StaticOrder, true, true>(F.lds + RING_OFF, g, S, E, F.wave); }
        if (BOTH(1)) GRID_BAR(1);
    }

    if (IN(2)) {
        pg8::Gemm g{ACT, Wd1, M, 1024, DFF}; pg8::StaticOrder S; S.init(M, 1024, F.G, (int)blockIdx.x);
        pg8::EpiResid E{KARG(I_XP), KARG(I_XS), X, XB, SS2, 0.5f};
        pg8::gemm_phase<pg8::EpiResid, pg8::StaticOrder, true, true>(F.lds + RING_OFF, g, S, E, F.wave);
        if (BOTH(2)) GRID_BAR(2);
    }

    if (IN(3)) {
        pg8::Gemm g{XB, Win, M, NIN, 1024}; pg8::StaticOrder S; S.init(M, NIN, F.G, (int)blockIdx.x);
        pg8::EpiWin E{ws, out};
        pg8::gemm_phase<pg8::EpiWin, pg8::StaticOrder, true, true>(F.lds + RING_OFF, g, S, E, F.wave);
        if (BOTH(3)) GRID_BAR(3);
    }

    if (IN(4)) {
        for (int u = blockIdx.x; u < NB + DB; u += F.G) {
            if (u < NB) scan_seq(F, out + O_LFP + (size_t)u * SEQ * 8, SEQ, nullptr, SEQ, FP2 + (size_t)u * 8 * SEQ, SEQ);
            else { const int b = u - NB; scan_seq(F, KARG(I_CFLF) + (size_t)b * PAST * 8, PAST, out + O_LFS + (size_t)b * DS * 8, PAST + DS, FS2 + (size_t)b * 8 * FSP, FSP); }
        }
        {
            const float* cw = (const float*)(ws + WS_PAR) + PAR_CW; const float* cb = (const float*)(ws + WS_PAR) + PAR_CB; const float* sc = KARG(I_SCONV);
            for (int i = blockIdx.x * (NWAVES * 64) + FTID; i < M * 32; i += F.G * NWAVES * 64) {
                const int row = i >> 5, ch = (i & 31) * 8;
                int t, T; const float* st = nullptr; float* ns;
                if (row < MP) { t = row & (SEQ - 1); T = SEQ; ns = out + O_CSP + (size_t)(row >> 13) * 512; }
                else { const int b = (row - MP) >> 5; t = (row - MP) & 31; T = DS; st = sc + (size_t)b * 512; ns = out + O_CSS + (size_t)b * 512; }
                const float* cp = CI + (size_t)row * 256 + ch;
                f32x4 c2[2] = {*(const f32x4*)cp, *(const f32x4*)(cp + 4)}, c1[2], c0[2];
                if (t >= 1) { c1[0] = *(const f32x4*)(cp - 256); c1[1] = *(const f32x4*)(cp - 252); }
                else if (st) { c1[0] = *(const f32x4*)(st + 256 + ch); c1[1] = *(const f32x4*)(st + 256 + ch + 4); }
                else { c1[0] = (f32x4){0.f, 0.f, 0.f, 0.f}; c1[1] = c1[0]; }
                if (t >= 2) { c0[0] = *(const f32x4*)(cp - 512); c0[1] = *(const f32x4*)(cp - 508); }
                else if (st) { c0[0] = *(const f32x4*)(st + (size_t)t * 256 + ch); c0[1] = *(const f32x4*)(st + (size_t)t * 256 + ch + 4); }
                else { c0[0] = (f32x4){0.f, 0.f, 0.f, 0.f}; c0[1] = c0[0]; }
                const v4u bgw = *(const v4u*)(BG + (size_t)row * 256 + ch);
                f32x4 y[2];
#pragma unroll
                for (int hh = 0; hh < 2; ++hh) {
                    const f32x4 w0 = *(const f32x4*)(cw + ch + 4 * hh), w1 = *(const f32x4*)(cw + 256 + ch + 4 * hh), w2 = *(const f32x4*)(cw + 512 + ch + 4 * hh), bb = *(const f32x4*)(cb + ch + 4 * hh);
                    const unsigned g0 = hh ? bgw.z : bgw.x, g1 = hh ? bgw.w : bgw.y;
                    const f32x4 gate = {__uint_as_float(g0 << 16), __uint_as_float(g0 & 0xffff0000u), __uint_as_float(g1 << 16), __uint_as_float(g1 & 0xffff0000u)};
                    y[hh] = gate * (bb + w0 * c0[hh] + w1 * c1[hh] + w2 * c2[hh]);
                }
                v4u o; o.x = pk2(y[0].x, y[0].y); o.y = pk2(y[0].z, y[0].w); o.z = pk2(y[1].x, y[1].y); o.w = pk2(y[1].z, y[1].w);
                *(v4u*)(MIX + (size_t)row * 1024 + ch) = o;
                if (t >= T - 2) { float* np = ns + (size_t)(t - (T - 2)) * 256 + ch; *(f32x4*)np = c2[0]; *(f32x4*)(np + 4) = c2[1]; }
            }
        }
        if (BOTH(4)) GRID_BAR(4);
    }


    if (IN(5)) {
        typedef attn_body::bf16 abf;
        char* shm = (char*)lds + RING_OFF; char* aux = (char*)lds + SAUX_OFF;
        for (int u = F.vcu; u < DB * FOXH; u += F.G) {
            const int b = u >> 3, h = u & 7;
            struct Tiles { const float *ck, *cv, *nk, *nv, *f2; float fr;
                __device__ __forceinline__ int ntiles(int w) const { return w == 7 ? 3 : 2; }
                __device__ __forceinline__ void tile(int w, int i, const float*& ks, const float*& vs, int& rstride, int& nvalid, const float*& bias, bool& cn) const {
                    if (i < 2) { const int t = 2 * w + i; ks = ck + (size_t)t * 64 * 512; vs = cv + (size_t)t * 64 * 512; rstride = 512; nvalid = 64; bias = f2 + 64 * t; cn = false; }
                    else { ks = nk; vs = nv; rstride = 512; nvalid = DS; bias = f2 + PAST; cn = true; } }
                __device__ __forceinline__ float fref() const { return fr; } };
            const float* f2 = FS2 + (size_t)(b * 8 + h) * FSP;
            Tiles T{KARG(I_CFK) + ((size_t)b * PAST * 8 + h) * 64, KARG(I_CFV) + ((size_t)b * PAST * 8 + h) * 64,
                    out + O_FKS + ((size_t)b * DS * 8 + h) * 64, out + O_FVS + ((size_t)b * DS * 8 + h) * 64, f2, f2[PAST]};
            attn_body::samp_unit(T, (const abf*)Qb + (size_t)(MP + b * DS) * 512 + h * 64, 512, (abf*)MIX + (size_t)(MP + b * DS) * 1024 + 256 + h * 64, 1024, shm, aux, F.wave);
        }
        for (int u = F.vcu; u < DB * MEMH; u += F.G) {
            const int b = u >> 2, h = u & 3;
            struct Tiles { const float *ck, *cv;
                __device__ __forceinline__ int ntiles(int w) const { return w < 4 ? 1 : 0; }
                __device__ __forceinline__ void tile(int w, int, const float*& ks, const float*& vs, int& rstride, int& nvalid, const float*& bias, bool& cn) const {
                    ks = ck + (size_t)w * 64 * 256; vs = cv + (size_t)w * 64 * 256; rstride = 256; nvalid = 64; bias = nullptr; cn = false; }
                __device__ __forceinline__ float fref() const { return 0.f; } };
            Tiles T{KARG(I_CMK) + ((size_t)b * NMEM * 4 + h) * 64, KARG(I_CMV) + ((size_t)b * NMEM * 4 + h) * 64};
            attn_body::samp_unit(T, (const abf*)QMb + (size_t)(MP + b * DS) * 256 + h * 64, 256, (abf*)MIX + (size_t)(MP + b * DS) * 1024 + 768 + h * 64, 1024, shm, aux, F.wave);
        }
        for (int u = F.vcu; u < NB * MEMH * 32; u += F.G) {
            const int b = u >> 7, h = (u >> 5) & 3, qb = u & 31; const size_t r0 = (size_t)b * SEQ + qb * 256;
            attn_body::attn_unit<8, false, false, 256, 256, 1024>((const abf*)QMb + r0 * 256 + h * 64, (const abf*)MKb + (size_t)b * NMEM * 256 + h * 64, (const abf*)MVb + (size_t)b * NMEM * 256 + h * 64,
                                                                 (abf*)MIX + r0 * 1024 + 768 + h * 64, 4, nullptr, 0, 0, shm, F.wave);
        }
        for (int u = F.vcu; u < NB * FOXH * 16; u += F.G) {
            const int bh = u >> 4, b = bh >> 3, h = bh & 7, s = u & 15;
            for (int k = 0; k < 2; ++k) {
                const int qb = k ? 31 - s : s; const size_t r0 = (size_t)b * SEQ + qb * 256;
                attn_body::attn_unit<8, true, true, 512, 512, 1024>((const abf*)Qb + r0 * 512 + h * 64, (const abf*)Kb + (size_t)b * SEQ * 512 + h * 64, (const abf*)Vb + (size_t)b * SEQ * 512 + h * 64,
                                                                   (abf*)MIX + r0 * 1024 + 256 + h * 64, 4 * qb + 4, FP2 + (size_t)bh * SEQ, 0, qb * 256, shm, F.wave);
            }
        }
        if (BOTH(5)) GRID_BAR(5);
    }

    if (IN(6)) {
        pg8::Gemm g{MIX, Wout, M, 1024, 1024}; pg8::StaticOrder S; S.init(M, 1024, F.G, (int)blockIdx.x);
        pg8::EpiResid E{X, X + (size_t)MP * 1024, X, XB, SS3, 1.0f};
        pg8::gemm_phase<pg8::EpiResid, pg8::StaticOrder, true, true>(F.lds + RING_OFF, g, S, E, F.wave);
        if (BOTH(6)) GRID_BAR(6);
    }

    if (IN(7)) {
        pg8::Gemm g{XB, Wgu2, M, NGU, 1024}; pg8::StaticOrder S; S.init(M, NGU, F.G, (int)blockIdx.x);
        pg8::EpiSwiGLU E{ACT, SS3};
        pg8::gemm_phase<pg8::EpiSwiGLU, pg8::StaticOrder, true, true>(F.lds + RING_OFF, g, S, E, F.wave);
        if (BOTH(7)) GRID_BAR(7);
    }

    if (IN(8)) {
        pg8::Gemm g{ACT, Wd2, M, 1024, DFF}; pg8::StaticOrder S; S.init(M, 1024, F.G, (int)blockIdx.x);
        pg8::EpiResid E{X, X + (size_t)MP * 1024, X, nullptr, SS4, 0.5f};
        pg8::gemm_phase<pg8::EpiResid, pg8::StaticOrder, true, true>(F.lds + RING_OFF, g, S, E, F.wave);
        if (BOTH(8)) GRID_BAR(8);
    }

    if (IN(9)) {
        const float* gf = (const float*)(ws + WS_PAR) + PAR_GFIN;
        unsigned bad = __hip_atomic_load(F.ctl + CW_TMO, RLX_AGENT) | __hip_atomic_load((gu32*)((unsigned*)(F.ctl + CW_BAR) + XB_TMO), RLX_AGENT);
        if (N_LAUNCHES == PER_PHASE) bad = 0u;
        for (int m = gw; m < M; m += NGW) {
            const float rs = bad ? __builtin_nanf("") : 1.0f / sqrtf(SS4[m] * (1.0f / 1024.0f) + EPSF);
            GAS f32x4* xr = (GAS f32x4*)(X + (size_t)m * 1024) + FLANE; const GAS f32x4* gr = (const GAS f32x4*)gf + FLANE;
#pragma unroll
            for (int j = 0; j < 4; ++j) xr[64 * j] = xr[64 * j] * rs * gr[64 * j];
        }
    }
#undef IN
#undef BOTH
#undef GRID_BAR
}

extern "C" void kernel_launch(void* const* d_in, const int* in_sizes, int n_in, void* d_out, int out_size, void* d_ws, size_t ws_size, hipStream_t stream) {
    static int grid = 0;
    if (grid == 0) {
        if (n_in != 30 || in_sizes[0] != MP * 1024 || out_size != (int)O_END || ws_size < WS_END) { fprintf(stderr, "kernel_launch: built for 30 inputs, %d x floats, %zu outputs, >= %zu bytes of workspace; got n_in %d, in0 %d, out %d, ws %zu; nothing launched\n", MP * 1024, (size_t)O_END, (size_t)WS_END, n_in, n_in > 0 ? in_sizes[0] : -1, out_size, ws_size); grid = -1; return; }
        int dev = 0, cus = 0, per_cu = 0;
        if (hipGetDevice(&dev) != hipSuccess || hipDeviceGetAttribute(&cus, hipDeviceAttributeMultiprocessorCount, dev) != hipSuccess) { fprintf(stderr, "kernel_launch: hipGetDevice / hipDeviceGetAttribute failed; nothing launched\n"); grid = -1; return; }
        if (hipFuncSetAttribute((const void*)hybrid_fwd, hipFuncAttributeMaxDynamicSharedMemorySize, LDS_BYTES) != hipSuccess) { fprintf(stderr, "kernel_launch: hipFuncSetAttribute failed (%d bytes of dynamic LDS); nothing launched\n", LDS_BYTES); grid = -1; return; }
        if (hipOccupancyMaxActiveBlocksPerMultiprocessor(&per_cu, (const void*)hybrid_fwd, NWAVES * 64, LDS_BYTES) != hipSuccess || per_cu < 1)
            fprintf(stderr, "kernel_launch: note: the occupancy query reports %d workgroups per CU; launching one per CU (%d bytes of LDS each)\n", per_cu, LDS_BYTES);
        (void)hipGetLastError();
        grid = cus;
        if (grid != 256) fprintf(stderr, "kernel_launch: note: %d CUs (the unit deals are tuned for 256)\n", grid);
    }
    if (grid < 0) return;
    if (hipMemsetAsync((char*)d_ws + WS_CTL, 0, CTL_ZERO_BYTES, stream) != hipSuccess) { fprintf(stderr, "kernel_launch: hipMemsetAsync of the control words failed; nothing launched\n"); return; }
    Args a{};
    for (int i = 0; i < 30; ++i) a.in[i] = (const float*)d_in[i];
    a.out = (float*)d_out; a.ws = (unsigned char*)d_ws;
    for (int li = 0; li < N_LAUNCHES; ++li) {
        a.ph_lo = (N_LAUNCHES == PER_PHASE) ? li : 0; a.ph_hi = (N_LAUNCHES == PER_PHASE) ? li + 1 : PER_PHASE;
        hipLaunchKernelGGL(hybrid_fwd, dim3(grid), dim3(NWAVES * 64), LDS_BYTES, stream, a);
        const hipError_t le = hipPeekAtLastError();
        if (le != hipSuccess) { fprintf(stderr, "kernel_launch: launch %d failed: %s (grid %d x %d threads, %d B LDS)\n", li, hipGetErrorName(le), grid, NWAVES * 64, LDS_BYTES); break; }
    }
}
```

```cpp
#include <hip/hip_runtime.h>
#include <cstdio>
#include <cstdint>
__device__ __forceinline__ int lane_of_wave() { return (int)__builtin_amdgcn_mbcnt_hi(~0u, __builtin_amdgcn_mbcnt_lo(~0u, 0u)); }
namespace pg8 {
#define PG8_LAS __attribute__((address_space(3)))
typedef unsigned short bf16_t;
typedef short bf16x8 __attribute__((ext_vector_type(8)));
typedef float f32x4 __attribute__((ext_vector_type(4)));
typedef unsigned u32x4 __attribute__((ext_vector_type(4)));
constexpr int BM = 256, BK = 64, HALF = 128, HTB = HALF * BK * 2  , STAGE_BYTES = 8 * HTB, NXCD = 8, WGM = 8;

__host__ __device__ __forceinline__ int lds_byte(int r, int c) { const int st = (r >> 4) * 2 + (c >> 5), rr = r & 15, cc = c & 31, ob = rr * 64 + cc * 2; return st * 1024 + (ob ^ (((ob >> 9) & 1) << 5)); }
__host__ __device__ __forceinline__ void stage_rc(int b, int& R, int& C) { const int st = b / 1024, sb = b % 1024, swz = sb ^ (((sb >> 9) & 1) << 5); R = (st >> 1) * 16 + swz / 64; C = (st & 1) * 32 + (swz % 64) / 2; }
__host__ __device__ __forceinline__ int perm32(int rho) { const int n = rho >> 4, i = rho & 15; return 8 * (i >> 2) + 4 * n + (i & 3); }

struct Unit { int pm, pn; };
struct Gemm { const bf16_t* A; const bf16_t* Bt; int M, N, K; };

struct StaticOrder {
    int nM, nN, nwg, G, c;
    __host__ __device__ void init(int M, int N, int G_, int c_) { nM = M / BM; nN = N / BM; nwg = nM * nN; G = G_; c = c_; }
    __host__ __device__ bool next(int i, Unit& u) const {
        const long L = (long)i * G + c; if (L >= nwg) return false;
        int wgid = (int)L; { const int q = nwg / NXCD, r = nwg % NXCD, xcd = wgid % NXCD, off = wgid / NXCD; wgid = (xcd < r ? xcd * (q + 1) : r * (q + 1) + (xcd - r) * q) + off; }
        const int nig = WGM * nN, gid = wgid / nig, fm = gid * WGM, gsz = (nM - fm) < WGM ? (nM - fm) : WGM;
        u.pm = fm + ((wgid % nig) % gsz); u.pn = (wgid % nig) / gsz; return true;
    }
    __device__ __forceinline__ void a_ready(const Unit&) const {}
    __device__ __forceinline__ void done(const Unit&) const {}
};
__device__ __forceinline__ unsigned cvt_pk_bf16(float lo, float hi) { unsigned r; asm volatile("v_cvt_pk_bf16_f32 %0, %1, %2" : "=v"(r) : "v"(lo), "v"(hi)); return r; }
typedef float f32x2 __attribute__((ext_vector_type(2)));
template <class Epi, class Sched, bool ALIGN_EPI = false, bool SP2 = false>
__device__ __forceinline__ void gemm_phase(PG8_LAS unsigned char* lds, const Gemm g, const Sched& S, const Epi& E, const int wid_) {
    int wid = wid_, lane = lane_of_wave(); asm volatile("" : "+s"(wid), "+v"(lane));
    const int tid = wid * 64 + lane, wr = wid >> 2, wc = wid & 3, fr = lane & 15, fq = lane >> 4;
    const int K = g.K, nt = K / BK;
    unsigned voffA[2], voffB[2];
#pragma unroll
    for (int i = 0; i < 2; ++i) { int R, C; stage_rc(tid * 16 + i * 8192, R, C); const int Rb = Epi::PERM ? ((R & ~31) + perm32(R & 31)) : R;
        voffA[i] = (unsigned)(R * K + C) * 2u; voffB[i] = (unsigned)(Rb * K + C) * 2u; }
    const size_t kstep = (size_t)(BK * 2);
    const size_t hstep = (size_t)HALF * K * 2;
    const size_t tstep = 2 * hstep;
    const unsigned ldsw = (unsigned)wid * 1024u;
    const int aoff = lds_byte(wr * 64 + fr, fq * 8), boff = lds_byte(wc * 32 + fr, fq * 8);
#define PG8_SA(b, h) (((b) * 2 + (h)) * HTB)
#define PG8_SB(b, h) ((4 + (b) * 2 + (h)) * HTB)
#define PG8_STAGE(bufoff, gbase, voff) do { _Pragma("unroll") for (int _i = 0; _i < 2; ++_i) \
        __builtin_amdgcn_global_load_lds((const unsigned*)((const char*)(gbase) + (voff)[_i]), (PG8_LAS unsigned*)(lds + (bufoff) + ldsw + _i * 8192), 16, 0, 0); } while (0)
#define PG8_LDA(dst, b, h) do { _Pragma("unroll") for (int m = 0; m < 4; ++m) _Pragma("unroll") for (int k = 0; k < 2; ++k) dst[m][k] = *(const PG8_LAS bf16x8*)(lds + PG8_SA(b, h) + aoff + m * 2048 + k * 1024); } while (0)
#define PG8_LDB(dst, b, h) do { _Pragma("unroll") for (int n = 0; n < 2; ++n) _Pragma("unroll") for (int k = 0; k < 2; ++k) dst[n][k] = *(const PG8_LAS bf16x8*)(lds + PG8_SB(b, h) + boff + n * 2048 + k * 1024); } while (0)
#define PG8_MMA(ai, bj, At, Bt) do { __builtin_amdgcn_s_setprio(1); _Pragma("unroll") for (int m = 0; m < 4; ++m) _Pragma("unroll") for (int n = 0; n < 2; ++n) _Pragma("unroll") for (int k = 0; k < 2; ++k) \
        acc[ai][bj][m][n] = __builtin_amdgcn_mfma_f32_16x16x32_bf16(Bt[n][k], At[m][k], acc[ai][bj][m][n], 0, 0, 0); __builtin_amdgcn_s_setprio(0); } while (0)
#define PG8_WAIT_V(n) asm volatile("s_waitcnt vmcnt(" #n ")" ::: "memory")
#define PG8_WAIT_L(n) asm volatile("s_waitcnt lgkmcnt(" #n ")" ::: "memory")
#define PG8_BAR __builtin_amdgcn_s_barrier()
#define PG8_SCHED __builtin_amdgcn_sched_barrier(0)
    Unit cur, nxt; int ui = 0;
    if (!S.next(0, cur)) return;
    f32x4 acc[2][2][4][2];
#pragma unroll
    for (int a = 0; a < 2; ++a)
#pragma unroll
        for (int b = 0; b < 2; ++b)
#pragma unroll
            for (int m = 0; m < 4; ++m)
#pragma unroll
                for (int n = 0; n < 2; ++n) acc[a][b][m][n] = (f32x4){0.f, 0.f, 0.f, 0.f};
    bf16x8 At[4][2], B0[2][2], B1[2][2];
    const char* cA = (const char*)g.A + (size_t)cur.pm * tstep; const char* cB = (const char*)g.Bt + (size_t)cur.pn * tstep;
    S.a_ready(cur);
    if constexpr (SP2) {
        PG8_STAGE(PG8_SB(0, 0), cB, voffB); PG8_STAGE(PG8_SB(0, 1), cB + hstep, voffB); PG8_STAGE(PG8_SA(0, 0), cA, voffA); PG8_STAGE(PG8_SA(0, 1), cA + hstep, voffA);
        if (wr == 1) PG8_BAR;
        PG8_WAIT_V(2); PG8_BAR;
        PG8_STAGE(PG8_SB(1, 0), cB + kstep, voffB); PG8_STAGE(PG8_SA(1, 0), cA + kstep, voffA); PG8_STAGE(PG8_SB(1, 1), cB + hstep + kstep, voffB);
        PG8_WAIT_V(6); PG8_BAR;
    } else {
        PG8_STAGE(PG8_SB(0, 0), cB, voffB); PG8_STAGE(PG8_SA(0, 0), cA, voffA); PG8_STAGE(PG8_SB(0, 1), cB + hstep, voffB); PG8_STAGE(PG8_SA(0, 1), cA + hstep, voffA);
        if (wr == 1) PG8_BAR;
        PG8_WAIT_V(4); PG8_BAR;
        PG8_STAGE(PG8_SB(1, 0), cB + kstep, voffB); PG8_STAGE(PG8_SA(1, 0), cA + kstep, voffA); PG8_STAGE(PG8_SB(1, 1), cB + hstep + kstep, voffB);
        PG8_WAIT_V(6); PG8_BAR;
    }
    for (;;) {
        const bool has_next = S.next(ui + 1, nxt);
        const char* nA = has_next ? (const char*)g.A + (size_t)nxt.pm * tstep : cA; const char* nB = has_next ? (const char*)g.Bt + (size_t)nxt.pn * tstep : cB;
        for (int t = 0; t < nt; t += 2) {
            const bool last = (t == nt - 2);
            const char* a1 = cA + (size_t)(t + 1) * kstep;
            const char* a2 = last ? nA : cA + (size_t)(t + 2) * kstep; const char* b2 = last ? nB : cB + (size_t)(t + 2) * kstep;
            const char* a3 = a2 + kstep; const char* b3 = b2 + kstep;
            if (last && has_next) S.a_ready(nxt);
            if constexpr (SP2) {
            PG8_LDB(B0, 0, 0); PG8_LDB(B1, 0, 1); PG8_SCHED; PG8_LDA(At, 0, 0); PG8_STAGE(PG8_SA(1, 1), a1 + hstep, voffA);
            PG8_WAIT_V(8); PG8_WAIT_L(0); PG8_BAR; PG8_MMA(0, 0, At, B0); PG8_MMA(0, 1, At, B1); PG8_BAR; PG8_SCHED;
            PG8_LDA(At, 0, 1); PG8_STAGE(PG8_SB(0, 0), b2, voffB); PG8_STAGE(PG8_SB(0, 1), b2 + hstep, voffB); PG8_STAGE(PG8_SA(0, 0), a2, voffA);
            PG8_WAIT_V(8); PG8_WAIT_L(0); PG8_BAR; PG8_MMA(1, 0, At, B0); PG8_MMA(1, 1, At, B1); PG8_BAR; PG8_SCHED;
            PG8_LDB(B0, 1, 0); PG8_LDB(B1, 1, 1); PG8_SCHED; PG8_LDA(At, 1, 0); PG8_STAGE(PG8_SA(0, 1), a2 + hstep, voffA);
            PG8_WAIT_V(8); PG8_WAIT_L(0); PG8_BAR; PG8_MMA(0, 0, At, B0); PG8_MMA(0, 1, At, B1); PG8_BAR; PG8_SCHED;
            PG8_LDA(At, 1, 1); PG8_STAGE(PG8_SB(1, 0), b3, voffB); PG8_STAGE(PG8_SB(1, 1), b3 + hstep, voffB); PG8_STAGE(PG8_SA(1, 0), a3, voffA);
            PG8_WAIT_V(8); PG8_WAIT_L(0); PG8_BAR; PG8_MMA(1, 0, At, B0); PG8_MMA(1, 1, At, B1); PG8_BAR; PG8_SCHED;
            } else {
            PG8_LDB(B0, 0, 0); PG8_SCHED; PG8_LDA(At, 0, 0); PG8_STAGE(PG8_SA(1, 1), a1 + hstep, voffA);
            PG8_WAIT_L(8); PG8_BAR; PG8_WAIT_L(0); PG8_MMA(0, 0, At, B0); PG8_BAR; PG8_SCHED;
            PG8_LDB(B1, 0, 1); PG8_STAGE(PG8_SB(0, 0), b2, voffB);
            PG8_BAR; PG8_WAIT_L(0); PG8_MMA(0, 1, At, B1); PG8_BAR;
            PG8_LDA(At, 0, 1); PG8_STAGE(PG8_SA(0, 0), a2, voffA);
            PG8_BAR; PG8_WAIT_L(0); PG8_MMA(1, 0, At, B0); PG8_BAR; PG8_SCHED;
            PG8_STAGE(PG8_SB(0, 1), b2 + hstep, voffB);
            PG8_WAIT_V(6); PG8_BAR; PG8_MMA(1, 1, At, B1); PG8_BAR;
            PG8_LDB(B0, 1, 0); PG8_SCHED; PG8_LDA(At, 1, 0); PG8_STAGE(PG8_SA(0, 1), a2 + hstep, voffA);
            PG8_WAIT_L(8); PG8_BAR; PG8_WAIT_L(0); PG8_MMA(0, 0, At, B0); PG8_BAR; PG8_SCHED;
            PG8_LDB(B1, 1, 1); PG8_STAGE(PG8_SB(1, 0), b3, voffB);
            PG8_BAR; PG8_WAIT_L(0); PG8_MMA(0, 1, At, B1); PG8_BAR;
            PG8_LDA(At, 1, 1); PG8_STAGE(PG8_SA(1, 0), a3, voffA);
            PG8_BAR; PG8_WAIT_L(0); PG8_MMA(1, 0, At, B0); PG8_BAR; PG8_SCHED;
            PG8_STAGE(PG8_SB(1, 1), b3 + hstep, voffB);
            PG8_WAIT_V(6); PG8_BAR; PG8_MMA(1, 1, At, B1); PG8_BAR;
            }
        }
        if constexpr (ALIGN_EPI) { if (wr == 0) PG8_BAR; }
        if constexpr (!Epi::AFTER_DRAIN) { E(acc, cur, wr, wc, fr, fq); S.done(cur); }
        if (!has_next) break;
#pragma unroll
        for (int a = 0; a < 2; ++a)
#pragma unroll
            for (int b = 0; b < 2; ++b)
#pragma unroll
                for (int m = 0; m < 4; ++m)
#pragma unroll
                    for (int n = 0; n < 2; ++n) acc[a][b][m][n] = (f32x4){0.f, 0.f, 0.f, 0.f};
        cur = nxt; cA = nA; cB = nB; ++ui;
        if constexpr (ALIGN_EPI) { if (wr == 1) PG8_BAR; }
    }
    PG8_WAIT_V(0);
    if constexpr (!ALIGN_EPI) { if (wr == 0) PG8_BAR; }
    PG8_BAR;
    if constexpr (Epi::AFTER_DRAIN) { E.fused(acc, cur, wr, wc, fr, fq, lds, wid, lane); S.done(cur); }
#undef PG8_SA
#undef PG8_SB
#undef PG8_STAGE
#undef PG8_LDA
#undef PG8_LDB
#undef PG8_MMA
#undef PG8_WAIT_V
#undef PG8_WAIT_L
#undef PG8_BAR
#undef PG8_SCHED
}
}

constexpr int NWAVES = 8;
#ifndef MK_N_LAUNCHES
#define MK_N_LAUNCHES 1
#endif
constexpr int PER_PHASE = 10;
constexpr int N_LAUNCHES = MK_N_LAUNCHES;
static_assert(N_LAUNCHES == 1 || N_LAUNCHES == PER_PHASE, "MK_N_LAUNCHES is 1 or PER_PHASE");

constexpr int DMODEL = 1024, NB = 2, SEQ = 8192, DB = 32, DS = 32, PAST = 1024, NMEM = 256;
constexpr int MP = NB * SEQ;
constexpr int MS = DB * DS;
constexpr int M = MP + MS;
constexpr int DFF = 2816, NGU = 2 * DFF, NIN = 2816  , INCOLS = 2568;
constexpr int FOXH = 8, MEMH = 4, CONVD = 256;
constexpr int MMEM = NB * NMEM;
constexpr int FSP = 1088;
constexpr float EPSF = 1e-6f;
constexpr size_t O_Y = 0;
constexpr size_t O_FKP = (size_t)M * 1024;
constexpr size_t O_FVP = O_FKP + (size_t)MP * 512;
constexpr size_t O_LFP = O_FVP + (size_t)MP * 512;
constexpr size_t O_CSP = O_LFP + (size_t)MP * 8;
constexpr size_t O_MKP = O_CSP + (size_t)NB * 2 * 256;
constexpr size_t O_MVP = O_MKP + (size_t)MMEM * 256;
constexpr size_t O_FKS = O_MVP + (size_t)MMEM * 256;
constexpr size_t O_FVS = O_FKS + (size_t)MS * 512;
constexpr size_t O_LFS = O_FVS + (size_t)MS * 512;
constexpr size_t O_CSS = O_LFS + (size_t)MS * 8;
constexpr size_t O_END = O_CSS + (size_t)DB * 2 * 256;
static_assert(O_END == 36070400, "d_out layout");

constexpr size_t MiB = 1u << 20;
constexpr size_t WS_CTL = 0, CTL_ZERO_BYTES = 1 * MiB;
constexpr size_t WS_WGU1 = 2 * MiB, WS_WD1 = 13 * MiB, WS_WIN = 19 * MiB, WS_WOUT = 25 * MiB, WS_WGU2 = 27 * MiB, WS_WD2 = 38 * MiB, WS_WMKV = 44 * MiB;
constexpr size_t WS_MEMB = 45 * MiB;
constexpr size_t WS_MK = 46 * MiB, WS_MV = WS_MK + 256 * 1024;
constexpr size_t WS_FP2 = 47 * MiB;
constexpr size_t WS_FS2 = WS_FP2 + 512 * 1024;
constexpr size_t WS_SS1 = 50 * MiB;
constexpr size_t WS_PAR = 51 * MiB;
constexpr int PAR_GQF = 0, PAR_GKF = 64, PAR_GQM = 128, PAR_GKM = 192, PAR_BF = 256, PAR_CW = 512, PAR_CB = 1280, PAR_GFIN = 2048, PAR_N = 3072, PAR_THR = 3072  ;
constexpr size_t WS_XB = 52 * MiB;
constexpr size_t WS_BIG = 86 * MiB;
constexpr size_t WS_ACT = WS_BIG;
constexpr size_t WS_Q = WS_BIG, WS_K = WS_Q + 17 * MiB, WS_V = WS_K + 17 * MiB, WS_QM = WS_V + 17 * MiB, WS_CI = WS_QM + 9 * MiB, WS_BG = WS_CI + 17 * MiB, WS_MIX = WS_BG + 9 * MiB;
constexpr size_t WS_END = WS_MIX + 34 * MiB;
static_assert(WS_ACT + (size_t)M * DFF * 2 <= 256 * MiB && WS_END <= 256 * MiB, "d_ws map fits 256 MiB");
static_assert((size_t)M * 512 * 2 <= 17 * MiB && (size_t)M * 256 * 2 <= 9 * MiB && (size_t)M * 256 * 4 <= 17 * MiB && (size_t)M * 1024 * 2 <= 34 * MiB, "d_ws map pieces");
static_assert(WS_FS2 + (size_t)DB * FOXH * FSP * 4 <= WS_SS1 && WS_SS1 + (size_t)M * 4 <= WS_XB && WS_XB + (size_t)M * 1024 * 2 <= WS_BIG, "d_ws map small pieces");
constexpr int CW_TMO = 0, CW_CODE = 1;
constexpr int CW_BAR = 4096;
constexpr int CW_SS2 = 65536, CW_SS3 = CW_SS2 + 32768, CW_SS4 = CW_SS3 + 32768;
constexpr int CW_SSD = CW_SS4 + 32768;
static_assert((CW_SSD + 32768) * 4 <= (int)CTL_ZERO_BYTES && M <= 32768, "CTL words inside the memset region");
#ifndef PROBE_DUP
#define PROBE_DUP (-1)
#endif

constexpr int RING_OFF = 0, RING_BYTES = 131072;
constexpr int LDSCTL_OFF = RING_BYTES, MISC_OFF = LDSCTL_OFF + 320;
constexpr int SAUX_OFF = RING_BYTES + 1024;
constexpr int LDS_BYTES = 147456;
static_assert(MISC_OFF + 128 <= SAUX_OFF && SAUX_OFF + 4096 <= LDS_BYTES, "LDS map");


namespace pg8 {
constexpr float RMS_EPS = 1e-6f;
constexpr float LOG2E = 1.4426950408889634f;
constexpr float QSCALE = 0.125f * 1.4426950408889634f;
typedef unsigned u32x2 __attribute__((ext_vector_type(2)));
__device__ __forceinline__ float rs_of(const float* ss, int row) { return 1.0f / sqrtf(ss[row] * (1.0f / 1024.0f) + RMS_EPS); }
__device__ __forceinline__ u32x4 pack8(const f32x4 a, const f32x4 b) { u32x4 w; w.x = cvt_pk_bf16(a[0], a[1]); w.y = cvt_pk_bf16(a[2], a[3]); w.z = cvt_pk_bf16(b[0], b[1]); w.w = cvt_pk_bf16(b[2], b[3]); return w; }

struct EpiSwiGLU {
    static constexpr bool PERM = true, AFTER_DRAIN = false;
    bf16_t* O; const float* ss;
    __device__ __forceinline__ void operator()(const f32x4 (&acc)[2][2][4][2], const Unit& u, int wr, int wc, int fr, int fq) const {
        const int row0 = u.pm * BM + wr * 64 + fr, col0 = u.pn * 128 + wc * 32 + 8 * fq;
#pragma unroll
        for (int ai = 0; ai < 2; ++ai)
#pragma unroll
            for (int m = 0; m < 4; ++m) {
                const int row = row0 + ai * HALF + m * 16; const float rs = rs_of(ss, row);
                f32x4 o[2];
#pragma unroll
                for (int n = 0; n < 2; ++n)
#pragma unroll
                    for (int j = 0; j < 4; ++j) { const float g = acc[ai][0][m][n][j] * rs, up = acc[ai][1][m][n][j] * rs;
                        const float e = __builtin_amdgcn_exp2f(-LOG2E * g); o[n][j] = g * __builtin_amdgcn_rcpf(1.0f + e) * up; }
                *(u32x4*)(O + (size_t)row * 2816 + col0) = pack8(o[0], o[1]);
            }
    }
};

struct EpiResid {
    static constexpr bool PERM = true, AFTER_DRAIN = false;
    const float* base0; const float* base1; float* X; bf16_t* XB; float* ss; float alpha;
    __device__ __forceinline__ void operator()(const f32x4 (&acc)[2][2][4][2], const Unit& u, int wr, int wc, int fr, int fq) const {
        const int row0 = u.pm * BM + wr * 64 + fr, col0 = u.pn * BM + wc * 32 + 8 * fq;
        const float* bp0 = (u.pm < 64) ? base0 + (size_t)row0 * 1024 : base1 + (size_t)(row0 - 16384) * 1024;
#pragma unroll
        for (int ai = 0; ai < 2; ++ai)
#pragma unroll
            for (int m = 0; m < 4; ++m) {
                const int row = row0 + ai * HALF + m * 16; const size_t ro = (size_t)(ai * HALF + m * 16) * 1024; float sq = 0.f;
#pragma unroll
                for (int bj = 0; bj < 2; ++bj) {
                    const float* bp = bp0 + ro + col0 + bj * HALF;
                    const f32x4 b0 = *(const f32x4*)bp, b1 = *(const f32x4*)(bp + 4);
                    const f32x4 x0 = b0 + acc[ai][bj][m][0] * alpha, x1 = b1 + acc[ai][bj][m][1] * alpha;
                    float* xp = X + (size_t)row * 1024 + col0 + bj * HALF; *(f32x4*)xp = x0; *(f32x4*)(xp + 4) = x1;
                    if (XB) *(u32x4*)(XB + (size_t)row * 1024 + col0 + bj * HALF) = pack8(x0, x1);
                    sq += (x0[0] * x0[0] + x0[1] * x0[1]) + (x0[2] * x0[2] + x0[3] * x0[3]) + (x1[0] * x1[0] + x1[1] * x1[1]) + (x1[2] * x1[2] + x1[3] * x1[3]);
                }
                sq += __shfl_xor(sq, 16); sq += __shfl_xor(sq, 32);
                if (fq == 0) unsafeAtomicAdd(ss + row, sq);
            }
    }
};

template <bool NORM> __device__ __forceinline__ void epi_heads(const f32x4 (&acc)[2][2][4][2], int row0, int rloc0, const float* ss, const float* gain, float scale,
                                                               bf16_t* ob, int obp, float* of, int ofp, int hcol, int fq) {
    f32x4 gv[2][2];
#pragma unroll
    for (int bj = 0; bj < 2; ++bj)
#pragma unroll
        for (int n = 0; n < 2; ++n) gv[bj][n] = NORM ? *(const f32x4*)(gain + 32 * bj + 8 * fq + 4 * n) * scale : (f32x4){scale, scale, scale, scale};
#pragma unroll
    for (int ai = 0; ai < 2; ++ai)
#pragma unroll
        for (int m = 0; m < 4; ++m) {
            const int dr = ai * HALF + m * 16; const float rs = ss ? rs_of(ss, row0 + dr) : 1.0f;
            f32x4 v[2][2]; float sq = 0.f;
#pragma unroll
            for (int bj = 0; bj < 2; ++bj)
#pragma unroll
                for (int n = 0; n < 2; ++n) { v[bj][n] = acc[ai][bj][m][n] * rs; const f32x4 t = v[bj][n]; sq += (t[0] * t[0] + t[1] * t[1]) + (t[2] * t[2] + t[3] * t[3]); }
            float hr = 1.0f;
            if (NORM) { sq += __shfl_xor(sq, 16); sq += __shfl_xor(sq, 32); hr = 1.0f / sqrtf(sq * (1.0f / 64.0f) + RMS_EPS); }
#pragma unroll
            for (int bj = 0; bj < 2; ++bj) {
                const f32x4 a = v[bj][0] * hr * gv[bj][0], b = v[bj][1] * hr * gv[bj][1];
                *(u32x4*)(ob + (size_t)(row0 + dr) * obp + hcol + 32 * bj + 8 * fq) = pack8(a, b);
                if (of) { float* fp = of + (size_t)(rloc0 + dr) * ofp + hcol + 32 * bj + 8 * fq; *(f32x4*)fp = a; *(f32x4*)(fp + 4) = b; }
            }
        }
}

struct EpiWin {
    static constexpr bool PERM = true, AFTER_DRAIN = false;
    unsigned char* ws; float* out;
    __device__ __forceinline__ void operator()(const f32x4 (&acc)[2][2][4][2], const Unit& u, int wr, int wc, int fr, int fq) const {
        const float* ss = (const float*)(ws + WS_CTL) + CW_SS2; const float* par = (const float*)(ws + WS_PAR);
        const int pn = u.pn, row0 = u.pm * BM + wr * 64 + fr; const bool samp = u.pm >= 64; const int rloc0 = row0 - (samp ? 16384 : 0);
        if (pn < 2) epi_heads<true>(acc, row0, rloc0, ss, par + PAR_GQF, QSCALE, (bf16_t*)(ws + WS_Q), 512, nullptr, 0, (pn * 4 + wc) * 64, fq);
        else if (pn < 4) epi_heads<true>(acc, row0, rloc0, ss, par + PAR_GKF, 1.0f, (bf16_t*)(ws + WS_K), 512, out + (samp ? O_FKS : O_FKP), 512, ((pn - 2) * 4 + wc) * 64, fq);
        else if (pn < 6) epi_heads<false>(acc, row0, rloc0, ss, nullptr, 1.0f, (bf16_t*)(ws + WS_V), 512, out + (samp ? O_FVS : O_FVP), 512, ((pn - 4) * 4 + wc) * 64, fq);
        else if (pn == 6) epi_heads<true>(acc, row0, rloc0, ss, par + PAR_GQM, QSCALE, (bf16_t*)(ws + WS_QM), 256, nullptr, 0, wc * 64, fq);
        else if (pn < 9) {
            float* CI = (float*)(ws + WS_CI);
            const int col0 = (pn - 7) * 128 + wc * 32 + 8 * fq;
#pragma unroll
            for (int ai = 0; ai < 2; ++ai)
#pragma unroll
                for (int m = 0; m < 4; ++m) { const int row = row0 + ai * HALF + m * 16; const float rs = rs_of(ss, row), r2 = rs * rs;
                    float* cp = CI + (size_t)row * 256 + col0;
                    *(f32x4*)cp = acc[ai][0][m][0] * acc[ai][1][m][0] * r2; *(f32x4*)(cp + 4) = acc[ai][0][m][1] * acc[ai][1][m][1] * r2; }
        } else if (pn == 9) {
            bf16_t* BG = (bf16_t*)(ws + WS_BG);
#pragma unroll
            for (int ai = 0; ai < 2; ++ai)
#pragma unroll
                for (int m = 0; m < 4; ++m) { const int row = row0 + ai * HALF + m * 16; const float rs = rs_of(ss, row);
#pragma unroll
                    for (int bj = 0; bj < 2; ++bj) *(u32x4*)(BG + (size_t)row * 256 + bj * HALF + wc * 32 + 8 * fq) = pack8(acc[ai][bj][m][0] * rs, acc[ai][bj][m][1] * rs); }
        } else {
            if (wc == 0 && fq == 0) {
                float* lf = out + (samp ? O_LFS : O_LFP); const float* bf = par + PAR_BF;
#pragma unroll
                for (int ai = 0; ai < 2; ++ai)
#pragma unroll
                    for (int m = 0; m < 4; ++m) { const int dr = ai * HALF + m * 16; const float rs = rs_of(ss, row0 + dr); f32x4 o[2];
#pragma unroll
                        for (int n = 0; n < 2; ++n)
#pragma unroll
                            for (int j = 0; j < 4; ++j) { const float z = acc[ai][0][m][n][j] * rs + bf[4 * n + j]; o[n][j] = fminf(z, 0.f) - log1pf(expf(-fabsf(z))); }
                        float* p = lf + (size_t)(rloc0 + dr) * 8; *(f32x4*)p = o[0]; *(f32x4*)(p + 4) = o[1]; }
            }
        }
    }
};

struct EpiMemKV {
    static constexpr bool PERM = true, AFTER_DRAIN = false;
    unsigned char* ws; float* out;
    __device__ __forceinline__ void operator()(const f32x4 (&acc)[2][2][4][2], const Unit& u, int wr, int wc, int fr, int fq) const {
        const int row0 = u.pm * BM + wr * 64 + fr;
        if (u.pn == 0) epi_heads<true>(acc, row0, row0, nullptr, (const float*)(ws + WS_PAR) + PAR_GKM, 1.0f, (bf16_t*)(ws + WS_MK), 256, out + O_MKP, 256, wc * 64, fq);
        else epi_heads<false>(acc, row0, row0, nullptr, nullptr, 1.0f, (bf16_t*)(ws + WS_MV), 256, out + O_MVP, 256, wc * 64, fq);
    }
};
}

#include <hip/hip_bf16.h>
#include <cmath>
namespace attn_body {
using bf16=__hip_bfloat16;
using bf16x8=__attribute__((ext_vector_type(8)))short;
using s16x4=__attribute__((ext_vector_type(4)))short;
using f32x16=__attribute__((ext_vector_type(16)))float;
using u32x4=__attribute__((ext_vector_type(4)))unsigned;
constexpr int D=64;
constexpr int NW=8,QBLK=32,QB=QBLK*NW,KVBLK=64;
__device__ __forceinline__ int crow(int r,int hi){return (r&3)+8*(r>>2)+4*hi;}
#define SBAR() __builtin_amdgcn_sched_barrier(0)
__device__ __forceinline__ void cmask(f32x16&p0,f32x16&p1,int jb,int qrel,int hi){
  const float NEG=-INFINITY; int kb=64*jb+4*hi;
  #pragma unroll
  for(int r=0;r<16;++r){int kv=kb+(r&3)+8*(r>>2); if(kv>qrel)p0[r]=NEG; if(kv+32>qrel)p1[r]=NEG;}
}
constexpr int NSLOT=3, SLOTB=8192;
constexpr int LDS_K=0, LDS_V=NSLOT*SLOTB, LDS_WS=2*NSLOT*SLOTB, LDS_OST=LDS_WS+NW*64*4, LDS_TAB=LDS_OST+NW*4096, TAB_BYTES=8192*4, LDS_BYTES=LDS_TAB+TAB_BYTES;
constexpr float C2=0.125f*1.4426950408889634f;
__device__ __forceinline__ void glds16(const void*gbase,unsigned voff,unsigned lds_dst){unsigned keep;
  asm volatile("s_mov_b32 %0, m0\n\ts_mov_b32 m0, %3\n\ts_nop 0\n\tglobal_load_lds_dwordx4 %1, %2\n\ts_mov_b32 m0, %0":"=&s"(keep):"v"(voff),"s"(gbase),"s"(lds_dst):"memory");}
__device__ __forceinline__ float max3f(float a,float b,float c){float r;asm("v_max3_f32 %0, %1, %2, %3":"=v"(r):"v"(a),"v"(b),"v"(c));return r;}
__device__ __forceinline__ float max2f(float a,float b){float r;asm("v_max_f32_e32 %0, %1, %2":"=v"(r):"v"(a),"v"(b));return r;}
__device__ __forceinline__ float fadd_s(float a,float b){float r;asm("v_add_f32_e32 %0, %1, %2":"=v"(r):"v"(a),"v"(b));return r;}
__device__ __forceinline__ float fsub_s(float a,float b){float r;asm("v_sub_f32_e32 %0, %1, %2":"=v"(r):"v"(a),"v"(b));return r;}
typedef float f32x2_t __attribute__((ext_vector_type(2))); typedef __bf16 bf16x2_t __attribute__((ext_vector_type(2)));
__device__ __forceinline__ unsigned cvtpk_s(float lo,float hi){f32x2_t v={lo,hi};bf16x2_t b=__builtin_convertvector(v,bf16x2_t);return __builtin_bit_cast(unsigned,b);}
#define WAIT_BAR(N) asm volatile("s_waitcnt vmcnt(" #N ") lgkmcnt(0)\n\ts_barrier":::"memory")

__device__ __forceinline__ void qkt(f32x16&p0,f32x16&p1,const char*Kslot,const bf16x8*qr,int r32,int hi){
  const char*kb=Kslot+hi*1024+r32*16;
  #pragma unroll
  for(int d0=0;d0<4;++d0){
    const bf16x8 b0=*reinterpret_cast<const bf16x8*>(kb+d0*2048);
    const bf16x8 b1=*reinterpret_cast<const bf16x8*>(kb+d0*2048+512);
    p0=__builtin_amdgcn_mfma_f32_32x32x16_bf16(b0,qr[d0],p0,0,0,0);p1=__builtin_amdgcn_mfma_f32_32x32x16_bf16(b1,qr[d0],p1,0,0,0);}
}
typedef __attribute__((address_space(3))) const char* lds_cptr;
typedef short v4i16_t __attribute__((ext_vector_type(4)));
__device__ __forceinline__ void kload8(bf16x8*kf,lds_cptr kp){
  kf[0]=*(const __attribute__((address_space(3))) bf16x8*)(kp);      kf[1]=*(const __attribute__((address_space(3))) bf16x8*)(kp+512);
  kf[2]=*(const __attribute__((address_space(3))) bf16x8*)(kp+2048); kf[3]=*(const __attribute__((address_space(3))) bf16x8*)(kp+2560);
  kf[4]=*(const __attribute__((address_space(3))) bf16x8*)(kp+4096); kf[5]=*(const __attribute__((address_space(3))) bf16x8*)(kp+4608);
  kf[6]=*(const __attribute__((address_space(3))) bf16x8*)(kp+6144); kf[7]=*(const __attribute__((address_space(3))) bf16x8*)(kp+6656);
}
__device__ __forceinline__ void kload2(bf16x8*kf,lds_cptr kp,int j){ kf[2*j]=*(const __attribute__((address_space(3))) bf16x8*)(kp+j*2048); kf[2*j+1]=*(const __attribute__((address_space(3))) bf16x8*)(kp+j*2048+512); }
__device__ __forceinline__ s16x4 vtr(lds_cptr p){ return __builtin_bit_cast(s16x4,__builtin_amdgcn_ds_read_tr16_b64_v4i16((__attribute__((address_space(3))) v4i16_t*)p)); }
__device__ __forceinline__ float rowmax(const f32x16&p0,const f32x16&p1){
  float a=max3f(p0[0],p0[1],p1[0]),b=max3f(p0[2],p0[3],p1[1]);a=max3f(a,p1[2],p1[3]);
  #pragma unroll
  for(int r=4;r<16;r+=4){a=max3f(a,p0[r],p0[r+1]);b=max3f(b,p0[r+2],p0[r+3]);a=max3f(a,p1[r],p1[r+1]);b=max3f(b,p1[r+2],p1[r+3]);}
  const float m=max2f(a,b);
  auto rr=__builtin_amdgcn_permlane32_swap(__float_as_uint(m),__float_as_uint(m),false,false);
  return max2f(__uint_as_float(rr[0]),__uint_as_float(rr[1]));
}
__device__ __forceinline__ void pv(f32x16*o,int vb,bf16x8 pa0,bf16x8 pa1,bf16x8 pa2,bf16x8 pa3){
  #pragma unroll
  for(int d0=0;d0<2;++d0){s16x4 lo[4],hi[4];
    #pragma unroll
    for(int ks=0;ks<4;++ks){
      asm volatile("ds_read_b64_tr_b16 %0,%1 offset:%c2":"=&v"(lo[ks]):"v"(vb),"i"(d0*4096+ks*1024):"memory");
      asm volatile("ds_read_b64_tr_b16 %0,%1 offset:%c2":"=&v"(hi[ks]):"v"(vb),"i"(d0*4096+ks*1024+512):"memory");}
    asm volatile("s_waitcnt lgkmcnt(0)":::"memory");SBAR();
    #define PK(k) (bf16x8){lo[k][0],lo[k][1],lo[k][2],lo[k][3],hi[k][0],hi[k][1],hi[k][2],hi[k][3]}
    o[d0]=__builtin_amdgcn_mfma_f32_32x32x16_bf16(pa0,PK(0),o[d0],0,0,0);
    o[d0]=__builtin_amdgcn_mfma_f32_32x32x16_bf16(pa1,PK(1),o[d0],0,0,0);
    o[d0]=__builtin_amdgcn_mfma_f32_32x32x16_bf16(pa2,PK(2),o[d0],0,0,0);
    o[d0]=__builtin_amdgcn_mfma_f32_32x32x16_bf16(pa3,PK(3),o[d0],0,0,0);
    #undef PK
  }
}

#ifndef ATTN_STORE16
#define ATTN_STORE16(p,v) (*(u32x4*)(p)=(v))
#endif
template<int THRL,bool CAUSAL,bool BIAS,int QP,int KP,int OP> __device__ __forceinline__ void attn_unit(const bf16*Qu,const bf16*__restrict__ Kh,const bf16*__restrict__ Vh,bf16*Ou,int NT,const float*F2,int s0,int q0abs,char*shm,const int wid_){
  int wid=wid_,lane=lane_of_wave(); asm volatile("":"+s"(wid),"+v"(lane)); const int tid=wid*64+lane,r32=lane&31,hi=lane>>5;
  const bf16*Qw=Qu+(long)wid*QBLK*QP;
  const unsigned lds0=(unsigned)(uintptr_t)shm;
  float*wsf=(float*)(shm+LDS_WS)+wid*64;
  const unsigned kvo=(unsigned)(lane*KP+wid*8)*2u;
  const unsigned vvo=(unsigned)((16*(wid&3)+(lane>>2))*KP+(wid>>2)*32+(lane&3)*8)*2u;
  const unsigned kdst=lds0+LDS_K+wid*1024, vdst=lds0+LDS_V+wid*1024;
  #define DMA_K(t,slot) glds16(Kh+(long)(t)*KVBLK*KP,kvo,(unsigned)__builtin_amdgcn_readfirstlane(kdst+(slot)))
  #define DMA_V(t,slot) glds16(Vh+(long)(t)*KVBLK*KP,vvo,(unsigned)__builtin_amdgcn_readfirstlane(vdst+(slot)))
  const int vb0=(int)(lds0+LDS_V)+((lane>>4)&1)*32+(lane&3)*8+(4*hi+((lane&15)>>2))*64;
  const char*Kbase=shm+LDS_K; bf16x8 kf[8];
  const lds_cptr shm3=(lds_cptr)shm; const lds_cptr kp0=shm3+LDS_K+hi*1024+r32*16; const lds_cptr vp0=shm3+LDS_V+((lane>>4)&1)*32+(lane&3)*8+(4*hi+((lane&15)>>2))*64;
  typedef __attribute__((address_space(3))) float lds_f32; typedef float f32x4_t __attribute__((ext_vector_type(4)));
  lds_f32*tab=(lds_f32*)(shm3+LDS_TAB);
  if(BIAS){ const float fref=F2[q0abs]; for(int s=tid;s<NT*KVBLK;s+=NW*64)tab[s]=fref-F2[s0+s]; }
  DMA_K(0,0);DMA_V(0,0);DMA_K(1,SLOTB);
  bf16x8 qr[4];
  #pragma unroll
  for(int d0=0;d0<4;++d0)qr[d0]=*reinterpret_cast<const bf16x8*>(&Qw[(long)r32*QP+d0*16+hi*8]);
  float mhat=0.f,l_reg=0.f;f32x16 o[2];o[0]=f32x16{};o[1]=f32x16{};
  #define CINIT(C0,C1,t) do{ if(BIAS){ const __attribute__((address_space(3))) f32x4_t*tp_=(const __attribute__((address_space(3))) f32x4_t*)(tab+(t)*KVBLK+4*hi); \
      _Pragma("unroll") for(int g_=0;g_<4;++g_){ const f32x4_t a_=tp_[2*g_], b_=tp_[2*g_+8]; \
        _Pragma("unroll") for(int i_=0;i_<4;++i_){ C0[4*g_+i_]=a_[i_]-mhat; C1[4*g_+i_]=b_[i_]-mhat; } } } \
    else { _Pragma("unroll") for(int r_=0;r_<16;++r_){ C0[r_]=-mhat; C1[r_]=-mhat; } } }while(0)
  const int qrel=wid*QBLK+r32;
  #define CMASK(P0,P1,t) do{int jb_=(t)-(NT-4); if(CAUSAL&&jb_>=0)cmask(P0,P1,jb_,qrel,hi);}while(0)
  bool resc=false;
  #define START(P0,P1) do{ const float rm=rowmax(P0,P1); resc=false; \
    { const float dl=rm; mhat=fadd_s(mhat,dl); \
      _Pragma("unroll") for(int r=0;r<16;++r){P0[r]=fsub_s(P0[r],dl);P1[r]=fsub_s(P1[r],dl);} \
      } \
    _Pragma("unroll") for(int r=0;r<16;++r)P0[r]=__builtin_amdgcn_exp2f(P0[r]); }while(0)
  #define RESC() do{ if(resc){ asm volatile("s_waitcnt lgkmcnt(0)":::"memory"); \
      _Pragma("unroll") for(int d_=0;d_<2;++d_) _Pragma("unroll") for(int r=0;r<16;++r)o[d_][r]*=wsf[crow(r,hi)]; } }while(0)
  f32x16 pA0,pA1,pB0,pB1;
  int sl_prev=0,sl_cur=0,sl_next=SLOTB;
  #define ROT() do{sl_prev=sl_cur;sl_cur=sl_next;sl_next=(sl_next==(NSLOT-1)*SLOTB)?0:sl_next+SLOTB;}while(0)
  DMA_K(2,2*SLOTB);
  WAIT_BAR(3);
  CINIT(pA0,pA1,0); qkt(pA0,pA1,Kbase,qr,r32,hi);asm volatile("s_nop 15\n\ts_nop 7":"+v"(pA0),"+v"(pA1));CMASK(pA0,pA1,0);
  START(pA0,pA1);
  _Pragma("unroll") for(int r=0;r<16;++r)pA1[r]=__builtin_amdgcn_exp2f(pA1[r]);
  WAIT_BAR(0);
  DMA_K(3,0);DMA_V(1,SLOTB);
  ROT();
  kload8(kf,kp0+sl_cur);
  WAIT_BAR(2);
  s16x4 vlo[8],vhi[8]; u32x4 pw0,pw1,pw2,pw3;
  #define PKW(P,B) cvtpk_s(P[B],P[B+1])
  #define PAF(k) __builtin_bit_cast(bf16x8,pw##k)
  #define VFR(i) (bf16x8){vlo[i][0],vlo[i][1],vlo[i][2],vlo[i][3],vhi[i][0],vhi[i][1],vhi[i][2],vhi[i][3]}
  #define PIN(x) asm volatile("":"+v"(x))
  #define MX3(a,b,c) __builtin_fmaxf(__builtin_fmaxf((a),(b)),(c))
  #define GAPA(MF,A0,A1,A2,A3,W0,W1,PW) do{ MF; sacc+=A0; sacc+=A1; sacc+=A2; sacc+=A3; PIN(sacc); W0; W1; PIN(PW); SBAR(); }while(0)
  #define EX(v) __builtin_amdgcn_exp2f(v)
  #define GAPB(MF,X,B) do{ MF; X[B]=EX(X[B]); X[B+1]=EX(X[B+1]); X[B+2]=EX(X[B+2]); X[B+3]=EX(X[B+3]); PIN(X); SBAR(); }while(0)
  #define VRD(i) do{ vlo[i]=vtr(vp_+(((i)>>2)*4096+((i)&3)*1024)); vhi[i]=vtr(vp_+(((i)>>2)*4096+((i)&3)*1024+512)); }while(0)
  #define KRD(G,j) do{ if(G){ kload2(kf,kp0+sl_next,j); SBAR(); } }while(0)
  #define STEP(C0,C1,P0,P1,t,GK,GV,GL) do{ CINIT(C0,C1,t); SBAR(); \
    const lds_cptr vp_=vp0+sl_prev; \
    VRD(0); SBAR(); float sacc=(P0[0]+P0[1]); \
    GAPA(C0=__builtin_amdgcn_mfma_f32_32x32x16_bf16(kf[0],qr[0],C0,0,0,0), P0[2],P0[3],P0[4],P0[5],     pw0[0]=PKW(P0,0), pw0[1]=PKW(P0,2), pw0); \
    VRD(4); SBAR(); GAPA(C1=__builtin_amdgcn_mfma_f32_32x32x16_bf16(kf[1],qr[0],C1,0,0,0), P0[6],P0[7],P0[8],P0[9],     pw0[2]=PKW(P0,4), pw0[3]=PKW(P0,6), pw0); \
    VRD(1); SBAR(); GAPA(C0=__builtin_amdgcn_mfma_f32_32x32x16_bf16(kf[2],qr[1],C0,0,0,0),   P0[10],P0[11],P0[12],P0[13], pw1[0]=PKW(P0,8), pw1[1]=PKW(P0,10), pw1); \
    VRD(5); SBAR(); GAPA(C1=__builtin_amdgcn_mfma_f32_32x32x16_bf16(kf[3],qr[1],C1,0,0,0),   P0[14],P0[15],P1[0],P1[1],   pw1[2]=PKW(P0,12),pw1[3]=PKW(P0,14), pw1); \
    VRD(2); SBAR(); GAPA(C0=__builtin_amdgcn_mfma_f32_32x32x16_bf16(kf[4],qr[2],C0,0,0,0),   P1[2],P1[3],P1[4],P1[5],     pw2[0]=PKW(P1,0), pw2[1]=PKW(P1,2), pw2); \
    VRD(6); SBAR(); GAPA(C1=__builtin_amdgcn_mfma_f32_32x32x16_bf16(kf[5],qr[2],C1,0,0,0),   P1[6],P1[7],P1[8],P1[9],     pw2[2]=PKW(P1,4), pw2[3]=PKW(P1,6), pw2); \
    VRD(3); SBAR(); GAPA(C0=__builtin_amdgcn_mfma_f32_32x32x16_bf16(kf[6],qr[3],C0,0,0,0),   P1[10],P1[11],P1[12],P1[13], pw3[0]=PKW(P1,8), pw3[1]=PKW(P1,10), pw3); \
    VRD(7); SBAR(); GAPA(C1=__builtin_amdgcn_mfma_f32_32x32x16_bf16(kf[7],qr[3],C1,0,0,0),   P1[14],P1[15],0.f,0.f,       pw3[2]=PKW(P1,12),pw3[3]=PKW(P1,14), pw3); \
    l_reg+=sacc; \
    if(GK){DMA_K((t)+3,sl_cur);} if(GV){DMA_V((t)+1,sl_next);} \
    CMASK(C0,C1,t); \
    { float a=MX3(C0[0],C0[1],C1[0]),b=MX3(C0[2],C0[3],C1[1]); a=MX3(a,C1[2],C1[3]); \
      _Pragma("unroll") for(int r=4;r<16;r+=4){a=MX3(a,C0[r],C0[r+1]);b=MX3(b,C0[r+2],C0[r+3]);a=MX3(a,C1[r],C1[r+1]);b=MX3(b,C1[r+2],C1[r+3]);} \
      float rm=__builtin_fmaxf(a,b); { auto rr=__builtin_amdgcn_permlane32_swap(__float_as_uint(rm),__float_as_uint(rm),false,false); rm=__builtin_fmaxf(__uint_as_float(rr[0]),__uint_as_float(rr[1])); } \
      resc=false; \
      if(__builtin_expect(__any(rm>(float)THRL),0)){ const float dl=__builtin_fmaxf(rm,0.f); mhat+=dl; \
        _Pragma("unroll") for(int r=0;r<16;++r){C0[r]-=dl;C1[r]-=dl;} \
        const float f=__builtin_amdgcn_exp2f(-dl); l_reg*=f; if(hi==0)wsf[r32]=f; resc=true; } } \
    SBAR(); \
    GAPB(o[0]=__builtin_amdgcn_mfma_f32_32x32x16_bf16(PAF(0),VFR(0),o[0],0,0,0), C0,0); \
    GAPB(o[1]=__builtin_amdgcn_mfma_f32_32x32x16_bf16(PAF(0),VFR(4),o[1],0,0,0), C0,4); \
    KRD(GL,0); GAPB(o[0]=__builtin_amdgcn_mfma_f32_32x32x16_bf16(PAF(1),VFR(1),o[0],0,0,0), C0,8); \
    KRD(GL,1); GAPB(o[1]=__builtin_amdgcn_mfma_f32_32x32x16_bf16(PAF(1),VFR(5),o[1],0,0,0), C0,12); \
    KRD(GL,2); GAPB(o[0]=__builtin_amdgcn_mfma_f32_32x32x16_bf16(PAF(2),VFR(2),o[0],0,0,0), C1,0); \
    KRD(GL,3); GAPB(o[1]=__builtin_amdgcn_mfma_f32_32x32x16_bf16(PAF(2),VFR(6),o[1],0,0,0), C1,4); \
    GAPB(o[0]=__builtin_amdgcn_mfma_f32_32x32x16_bf16(PAF(3),VFR(3),o[0],0,0,0), C1,8); \
    GAPB(o[1]=__builtin_amdgcn_mfma_f32_32x32x16_bf16(PAF(3),VFR(7),o[1],0,0,0), C1,12); \
    }while(0)
  int t=1;
  #undef CMASK
  #define CMASK(P0,P1,t) do{}while(0)
  for(;t+5<NT;t+=2){
    STEP(pB0,pB1,pA0,pA1,t,true,true,true);     WAIT_BAR(2); RESC(); ROT();
    STEP(pA0,pA1,pB0,pB1,t+1,true,true,true);   WAIT_BAR(2); RESC(); ROT();
  }
  #undef CMASK
  #define CMASK(P0,P1,t) do{int jb_=(t)-(NT-4); if(CAUSAL&&jb_>=0)cmask(P0,P1,jb_,qrel,hi);}while(0)
  #define ENDW(tt) do{ if((tt)+3<NT){WAIT_BAR(2);} else if((tt)+2<NT){WAIT_BAR(1);} else {WAIT_BAR(0);} }while(0)
  for(;t+1<NT;t+=2){
    STEP(pB0,pB1,pA0,pA1,t,(t+3<NT),(t+1<NT),(t+1<NT));       ENDW(t);   RESC(); ROT();
    STEP(pA0,pA1,pB0,pB1,t+1,(t+4<NT),(t+2<NT),(t+2<NT));     ENDW(t+1); RESC(); ROT();
  }
  STEP(pB0,pB1,pA0,pA1,NT-1,false,false,false); RESC();
  { float sacc=pB0[0]+pB0[1]; _Pragma("unroll") for(int r=2;r<16;++r)sacc+=pB0[r]; _Pragma("unroll") for(int r=0;r<16;++r)sacc+=pB1[r]; l_reg+=sacc;
    pw0=(u32x4){PKW(pB0,0),PKW(pB0,2),PKW(pB0,4),PKW(pB0,6)};pw1=(u32x4){PKW(pB0,8),PKW(pB0,10),PKW(pB0,12),PKW(pB0,14)};pw2=(u32x4){PKW(pB1,0),PKW(pB1,2),PKW(pB1,4),PKW(pB1,6)};pw3=(u32x4){PKW(pB1,8),PKW(pB1,10),PKW(pB1,12),PKW(pB1,14)};
    SBAR(); pv(o,vb0+sl_cur,PAF(0),PAF(1),PAF(2),PAF(3)); }
  #undef PKW
  #undef PAF
  #undef VFR
  #undef PIN
  #undef MX3
  #undef GAPA
  #undef GAPB
  #undef EX
  #undef VRD
  #undef KRD
  #undef STEP
  #undef ENDW
  {auto rr=__builtin_amdgcn_permlane32_swap(__float_as_uint(l_reg),__float_as_uint(l_reg),false,false);l_reg=__uint_as_float(rr[0])+__uint_as_float(rr[1]);}
  if(hi==0)wsf[32+r32]=l_reg;asm volatile("s_waitcnt lgkmcnt(0)":::"memory");
  float rli[16];
  #pragma unroll
  for(int r=0;r<16;++r)rli[r]=__builtin_amdgcn_rcpf(wsf[32+crow(r,hi)]);
  bf16*Ow=Ou+(long)wid*QBLK*OP;
  { bf16*stg=(bf16*)(shm+LDS_OST)+wid*2048;
    #pragma unroll
    for(int r=0;r<16;++r){const int orow=crow(r,hi);
      #pragma unroll
      for(int d0=0;d0<2;++d0)stg[orow*64+d0*32+r32]=__float2bfloat16(o[d0][r]*rli[r]);}
    asm volatile("s_waitcnt lgkmcnt(0)":::"memory");
    #pragma unroll
    for(int i=0;i<4;++i){const int row=i*8+(lane>>3),ch=lane&7; const u32x4 v=*(const u32x4*)(stg+row*64+ch*8); ATTN_STORE16(Ow+(long)row*OP+ch*8,v);} }
  asm volatile("s_waitcnt lgkmcnt(0)\n\ts_barrier":::"memory");
  #undef CINIT
  #undef DMA_K
  #undef DMA_V
  #undef CMASK
  #undef START
  #undef RESC
  #undef ROT
}

typedef __attribute__((address_space(3))) char* lds_ptr;
typedef float f32x4s __attribute__((ext_vector_type(4)));
__device__ __forceinline__ u32x4 pack8s(const f32x4s a,const f32x4s b){ u32x4 w; w.x=cvtpk_s(a[0],a[1]); w.y=cvtpk_s(a[2],a[3]); w.z=cvtpk_s(b[0],b[1]); w.w=cvtpk_s(b[2],b[3]); return w; }
__device__ __forceinline__ void samp_stage(const float*Ksrc,const float*Vsrc,int rstride,int nvalid,lds_ptr Kslot,lds_ptr Vslot,int lane){
  const int r0=lane>>2,q4=lane&3;
  #pragma unroll
  for(int i=0;i<4;++i){ const int r=r0+16*i;
    f32x4s k0={0.f,0.f,0.f,0.f},k1=k0,k2=k0,k3=k0,v0=k0,v1=k0,v2=k0,v3=k0;
    if(r<nvalid){ const f32x4s*kp=(const f32x4s*)(Ksrc+(size_t)r*rstride+q4*16); const f32x4s*vp=(const f32x4s*)(Vsrc+(size_t)r*rstride+q4*16);
      k0=kp[0];k1=kp[1];k2=kp[2];k3=kp[3]; v0=vp[0];v1=vp[1];v2=vp[2];v3=vp[3]; }
    *(__attribute__((address_space(3))) u32x4*)(Kslot+(2*q4)*1024+r*16)=pack8s(k0,k1);
    *(__attribute__((address_space(3))) u32x4*)(Kslot+(2*q4+1)*1024+r*16)=pack8s(k2,k3);
    *(__attribute__((address_space(3))) u32x4*)(Vslot+(q4>>1)*4096+r*64+(q4&1)*32)=pack8s(v0,v1);
    *(__attribute__((address_space(3))) u32x4*)(Vslot+(q4>>1)*4096+r*64+(q4&1)*32+16)=pack8s(v2,v3);
  }
}
__device__ __forceinline__ float rowmax_c(const f32x16&p0,const f32x16&p1){
  float a=__builtin_fmaxf(p0[0],p1[0]);
  #pragma unroll
  for(int r=1;r<16;++r)a=__builtin_fmaxf(a,__builtin_fmaxf(p0[r],p1[r]));
  auto rr=__builtin_amdgcn_permlane32_swap(__float_as_uint(a),__float_as_uint(a),false,false);
  return __builtin_fmaxf(__uint_as_float(rr[0]),__uint_as_float(rr[1]));
}
struct SampState { float mhat,l; f32x16 o[2]; };
__device__ __forceinline__ void samp_tile(SampState&st,const bf16x8*qr,lds_ptr Kslot,lds_ptr Vslot,const float*bias,float fref,bool causal_new,int nvalid,__attribute__((address_space(3))) float*wsf,int lane){
  const int r32=lane&31,hi=lane>>5;
  f32x16 p0,p1;
  #pragma unroll
  for(int g=0;g<4;++g){ f32x4s a={0.f,0.f,0.f,0.f},b=a;
    if(bias){ a=*(const f32x4s*)(bias+8*g+4*hi); a=fref-a; if(nvalid>32){ b=*(const f32x4s*)(bias+32+8*g+4*hi); b=fref-b; } }
    #pragma unroll
    for(int i=0;i<4;++i){p0[4*g+i]=a[i];p1[4*g+i]=b[i];} }
  { const lds_cptr kb=(lds_cptr)Kslot+hi*1024+r32*16;
    #pragma unroll
    for(int d0=0;d0<4;++d0){
      const bf16x8 b0=*(const __attribute__((address_space(3))) bf16x8*)(kb+d0*2048);
      const bf16x8 b1=*(const __attribute__((address_space(3))) bf16x8*)(kb+d0*2048+512);
      p0=__builtin_amdgcn_mfma_f32_32x32x16_bf16(b0,qr[d0],p0,0,0,0);p1=__builtin_amdgcn_mfma_f32_32x32x16_bf16(b1,qr[d0],p1,0,0,0);} }
  #pragma unroll
  for(int r=0;r<16;++r){ const int kv=crow(r,hi); const bool ok0=(kv<nvalid)&&(!causal_new||kv<=r32), ok1=(kv+32<nvalid)&&(!causal_new||kv+32<=r32);
    if(!ok0)p0[r]=-INFINITY; if(!ok1)p1[r]=-INFINITY; }
  const float rm=rowmax_c(p0,p1), mnew=__builtin_fmaxf(st.mhat,rm), alpha=__builtin_amdgcn_exp2f(st.mhat-mnew);
  float ls=0.f;
  #pragma unroll
  for(int r=0;r<16;++r){ p0[r]=__builtin_amdgcn_exp2f(p0[r]-mnew); p1[r]=__builtin_amdgcn_exp2f(p1[r]-mnew); ls+=p0[r]+p1[r]; }
  st.l=st.l*alpha+ls; st.mhat=mnew;
  if(hi==0)wsf[r32]=alpha;
  asm volatile("s_waitcnt lgkmcnt(0)":::"memory");
  #pragma unroll
  for(int r=0;r<16;++r){ const float a=wsf[crow(r,hi)]; st.o[0][r]*=a; st.o[1][r]*=a; }
  u32x4 pw0,pw1,pw2,pw3;
  pw0=(u32x4){cvtpk_s(p0[0],p0[1]),cvtpk_s(p0[2],p0[3]),cvtpk_s(p0[4],p0[5]),cvtpk_s(p0[6],p0[7])};
  pw1=(u32x4){cvtpk_s(p0[8],p0[9]),cvtpk_s(p0[10],p0[11]),cvtpk_s(p0[12],p0[13]),cvtpk_s(p0[14],p0[15])};
  pw2=(u32x4){cvtpk_s(p1[0],p1[1]),cvtpk_s(p1[2],p1[3]),cvtpk_s(p1[4],p1[5]),cvtpk_s(p1[6],p1[7])};
  pw3=(u32x4){cvtpk_s(p1[8],p1[9]),cvtpk_s(p1[10],p1[11]),cvtpk_s(p1[12],p1[13]),cvtpk_s(p1[14],p1[15])};
  const int vb=(int)(unsigned)(uintptr_t)Vslot+((lane>>4)&1)*32+(lane&3)*8+(4*hi+((lane&15)>>2))*64;
  asm volatile("s_waitcnt lgkmcnt(0)":::"memory"); SBAR();
  pv(st.o,vb,__builtin_bit_cast(bf16x8,pw0),__builtin_bit_cast(bf16x8,pw1),__builtin_bit_cast(bf16x8,pw2),__builtin_bit_cast(bf16x8,pw3));
}
template<class Tiles> __device__ __forceinline__ void samp_unit(const Tiles&T,const bf16*Qu,int QP,bf16*Ou,int OP,char*shm,char*aux,const int wid_){
  int wid=wid_,lane=lane_of_wave(); asm volatile("":"+s"(wid),"+v"(lane)); const int tid=wid*64+lane,r32=lane&31,hi=lane>>5;
  const lds_ptr Kslot=(lds_ptr)shm+wid*16384, Vslot=Kslot+8192;
  __attribute__((address_space(3))) float*wsf=(__attribute__((address_space(3))) float*)((lds_ptr)aux+wid*128);
  __attribute__((address_space(3))) float*ml=(__attribute__((address_space(3))) float*)((lds_ptr)aux+1024);
  bf16x8 qr[4];
  #pragma unroll
  for(int d0=0;d0<4;++d0)qr[d0]=*reinterpret_cast<const bf16x8*>(&Qu[(long)r32*QP+d0*16+hi*8]);
  SampState st; st.mhat=-1e30f; st.l=0.f; st.o[0]=f32x16{}; st.o[1]=f32x16{};
  const int nt=T.ntiles(wid);
  for(int i=0;i<nt;++i){
    const float*ks;const float*vs;int rstride,nvalid;const float*bias;bool cn; T.tile(wid,i,ks,vs,rstride,nvalid,bias,cn);
    samp_stage(ks,vs,rstride,nvalid,Kslot,Vslot,lane);
    asm volatile("s_waitcnt lgkmcnt(0)":::"memory");
    samp_tile(st,qr,Kslot,Vslot,bias,T.fref(),cn,nvalid,wsf,lane);
    asm volatile("s_waitcnt lgkmcnt(0)":::"memory");
  }
  { auto rr=__builtin_amdgcn_permlane32_swap(__float_as_uint(st.l),__float_as_uint(st.l),false,false); st.l=__uint_as_float(rr[0])+__uint_as_float(rr[1]); }
  if(hi==0){ ml[wid*64+r32]=st.mhat; ml[wid*64+32+r32]=st.l; }
  { __attribute__((address_space(3))) float*op=(__attribute__((address_space(3))) float*)Kslot;
    #pragma unroll
    for(int r=0;r<16;++r){ const int q=crow(r,hi); op[q*64+r32]=st.o[0][r]; op[q*64+32+r32]=st.o[1][r]; } }
  asm volatile("s_waitcnt lgkmcnt(0)\n\ts_barrier":::"memory");
  { const int q=tid>>4,d4=(tid&15)*4; float mw[8],M=-3e38f;
    #pragma unroll
    for(int w=0;w<8;++w){ mw[w]=ml[w*64+q]; M=__builtin_fmaxf(M,mw[w]); }
    float L=0.f; f32x4s acc={0.f,0.f,0.f,0.f};
    #pragma unroll
    for(int w=0;w<8;++w){ const float f=__builtin_amdgcn_exp2f(mw[w]-M); L+=f*ml[w*64+32+q];
      const f32x4s ov=*(const __attribute__((address_space(3))) f32x4s*)((lds_ptr)shm+w*16384+(q*64+d4)*4); acc+=ov*f; }
    const float inv=1.0f/L; typedef unsigned u32x2s __attribute__((ext_vector_type(2)));
    u32x2s w2; w2.x=cvtpk_s(acc[0]*inv,acc[1]*inv); w2.y=cvtpk_s(acc[2]*inv,acc[3]*inv);
    *(u32x2s*)(Ou+(long)q*OP+d4)=w2; }
  asm volatile("s_waitcnt lgkmcnt(0)\n\ts_barrier":::"memory");
}
#undef SBAR
#undef WAIT_BAR
}

static_assert(attn_body::LDS_BYTES <= RING_BYTES, "attention LDS fits the ring region");
#define GAS __attribute__((address_space(1)))
#define LAS __attribute__((address_space(3)))
typedef unsigned short bf16;
typedef unsigned v4u __attribute__((ext_vector_type(4)));
typedef float f32x4 __attribute__((ext_vector_type(4)));
typedef short bf16x8 __attribute__((ext_vector_type(8)));
typedef GAS unsigned gu32;
typedef GAS unsigned long long gu64;
#define RLX_AGENT __ATOMIC_RELAXED, __HIP_MEMORY_SCOPE_AGENT
#define LDS_WAIT() asm volatile("s_waitcnt lgkmcnt(0)" ::: "memory")
#define VM_WAIT() asm volatile("s_waitcnt vmcnt(0)" ::: "memory")
__device__ __forceinline__ unsigned long long rt() { return __builtin_amdgcn_s_memrealtime(); }
__device__ __forceinline__ unsigned f2bf(float f) { unsigned u = __builtin_bit_cast(unsigned, f); return (u + 0x7fffu + ((u >> 16) & 1u)) >> 16; }
__device__ __forceinline__ unsigned pk2(float lo, float hi) { return f2bf(lo) | (f2bf(hi) << 16); }


#define XB_TMO      128
#define XB_XCNT(j)  (256  + 64 * (j))
#define XB_XSUB(j)  (1280 + 64 * (j))
#define XB_XGEN(j)  (2304 + 64 * (j))
#define XB_TOP      3328
#define XB_TOPGEN   3392
#define XCD_BAR_WORDS 3456
#define XB_SPIN_CAP (1u << 18)

__device__ __forceinline__ unsigned xb_ld(unsigned* p)              { return __hip_atomic_load(p, __ATOMIC_RELAXED, __HIP_MEMORY_SCOPE_AGENT); }
__device__ __forceinline__ unsigned xb_add(unsigned* p, unsigned v) { return __hip_atomic_fetch_add(p, v, __ATOMIC_RELAXED, __HIP_MEMORY_SCOPE_AGENT); }
__device__ __forceinline__ unsigned xb_xcc_id() { return (unsigned)__builtin_amdgcn_s_getreg((3 << 11) | 20) & 0xFu; }
#define XB_SPIN(cond, bar) do { unsigned _sp = 0; while (cond) { __builtin_amdgcn_s_sleep(1); \
    if ((++_sp & 255u) == 0u) { if (xb_ld(&(bar)[XB_TMO])) break; if (_sp > XB_SPIN_CAP) { atomicAdd(&(bar)[XB_TMO], 1u); break; } } } } while (0)

struct XcdBarrier {
    unsigned* bar; unsigned x; int wv;
    volatile LAS unsigned* st;
};

__device__ __forceinline__ XcdBarrier xcd_barrier_post(unsigned* bar, volatile LAS unsigned* st, int wv) {
    XcdBarrier b; b.bar = bar; b.x = xb_xcc_id(); b.st = st; b.wv = wv;
    if (wv == 0 && lane_of_wave() == 0) (void)xb_add(&bar[XB_XCNT(b.x)], 1u);
    return b;
}
__device__ __forceinline__ void xcd_barrier_complete(unsigned* bar, unsigned x, unsigned& nloc, unsigned& nx) {
    const unsigned G = gridDim.x * gridDim.y * gridDim.z;
    unsigned sum, cnt, mine, sp = 0u;
    for (;;) {
        sum = 0u; cnt = 0u; mine = 0u;
#pragma unroll
        for (unsigned j = 0; j < 16; ++j) { const unsigned c = xb_ld(&bar[XB_XCNT(j)]); sum += c; cnt += (c > 0u) ? 1u : 0u; mine = (j == x) ? c : mine; }
        if (sum == G) break;
        __builtin_amdgcn_s_sleep(1);
        if ((++sp & 255u) == 0u) { if (xb_ld(&bar[XB_TMO])) break; if (sp > XB_SPIN_CAP) { atomicAdd(&bar[XB_TMO], 1u); break; } }
    }
    nloc = mine > 0u ? mine : 1u; nx = cnt > 0u ? cnt : 1u;
}

__device__ __forceinline__ void xcd_barrier(const XcdBarrier& b) {
    asm volatile("s_waitcnt vmcnt(0)" ::: "memory");
    __syncthreads();
    if (b.wv == 0 && lane_of_wave() == 0) {
        unsigned* bar = b.bar;
        __builtin_amdgcn_s_waitcnt(0);
        unsigned nloc = b.st[0], nx = b.st[1];
        if (nloc == 0u) { xcd_barrier_complete(bar, b.x, nloc, nx); b.st[0] = nloc; b.st[1] = nx; }
        const unsigned old = xb_add(&bar[XB_XSUB(b.x)], 1u);
        const unsigned gen = old / nloc;
        if (old + 1u == (gen + 1u) * nloc) {
            __builtin_amdgcn_fence(__ATOMIC_RELEASE, "agent");
            asm volatile("s_waitcnt vmcnt(0)" ::: "memory");
            const unsigned og = xb_add(&bar[XB_TOP], 1u);
            const unsigned tg = og / nx;
            if (og + 1u == (tg + 1u) * nx) xb_add(&bar[XB_TOPGEN], 1u);
            else XB_SPIN(xb_ld(&bar[XB_TOPGEN]) == tg, bar);
            __builtin_amdgcn_fence(__ATOMIC_ACQUIRE, "agent");
            xb_add(&bar[XB_XGEN(b.x)], 1u);
            asm volatile("s_waitcnt vmcnt(0)" ::: "memory");
        } else {
            XB_SPIN(xb_ld(&bar[XB_XGEN(b.x)]) == gen, bar);
            __builtin_amdgcn_fence(__ATOMIC_ACQUIRE, "agent");
            asm volatile("s_waitcnt vmcnt(0)" ::: "memory");
        }
    }
    __syncthreads();
}


struct Args { const float* in[30]; float* out; unsigned char* ws; int ph_lo, ph_hi; };
typedef const float* const __attribute__((address_space(4))) * karg_tab_t;
__device__ __forceinline__ const float* karg(int i) { auto p = __builtin_amdgcn_kernarg_segment_ptr(); asm volatile("" : "+s"(p)); return ((karg_tab_t)p)[i]; }
#define KARG(i) karg(i)
static_assert(sizeof(Args) == 32 * 8 + 8, "Args has no padding");
enum InIdx { I_XP = 0, I_XS, I_CFK, I_CFV, I_CFLF, I_SCONV, I_CMK, I_CMV, I_MEMP, I_NF1, I_WG1, I_WU1, I_WD1, I_NMIX, I_WIN, I_BF, I_CW, I_CB, I_GQF, I_GKF, I_GQM, I_GKM, I_NMEM, I_WMKV, I_WOUT, I_NF2, I_WG2, I_WU2, I_WD2, I_NFIN };

struct Frame {
    LAS unsigned char* lds;
    volatile LAS unsigned* MISC;
    int wave;
    int vcu, G;
};

#define FLANE lane_of_wave()
#define FTID (F.wave * 64 + lane_of_wave())
__device__ __forceinline__ float wave_sum(float v) {
#pragma unroll
    for (int o = 1; o < 64; o <<= 1) v += __shfl_xor(v, o);
    return v;
}

enum SegKind { SK_IDENT = 0, SK_GATE, SK_UP, SK_WIN_U, SK_WIN_C, SK_WIN_B, SK_HEADS };
__device__ __forceinline__ int dst_row(int kind, int pn0, int e) {
    switch (kind) {
        case SK_GATE:  return 256 * (e >> 7) + (e & 127);
        case SK_UP:    return 256 * (e >> 7) + 128 + (e & 127);
        case SK_WIN_U: return 256 * (7 + (e >> 7)) + (e & 127);
        case SK_WIN_C: return 256 * (7 + (e >> 7)) + 128 + (e & 127);
        case SK_WIN_B: return 256 * 9 + e;
        case SK_HEADS: { const int head = e >> 6, d = e & 63; return 256 * (pn0 + (head >> 2)) + 128 * (d >> 5) + 32 * (head & 3) + (d & 31); }
        default:       return e;
    }
}
__device__ __forceinline__ void p0_transpose_item(const float* W, int ldw, int K, int scol, int ncols, bf16* WT, int kind, int pn0, const float* gain, LAS float* scr, int item, int lane) {
    const int nblk = ncols / 32, kb = item / nblk, nb = item % nblk, k0 = 64 * kb, e0 = 32 * nb;
#pragma unroll 8
    for (int i = 0; i < 32; ++i) { const int kk = 2 * i + (lane >> 5); const float g = gain ? gain[k0 + kk] : 1.0f; scr[kk * 33 + (lane & 31)] = W[(size_t)(k0 + kk) * ldw + scol + e0 + (lane & 31)] * g; }
    LDS_WAIT(); asm volatile("" ::: "memory");
    const int c = lane & 7; const int r0 = dst_row(kind, pn0, e0);
#pragma unroll
    for (int j = 0; j < 4; ++j) { const int n = (lane >> 3) + 8 * j; const LAS float* s = scr + (8 * c) * 33 + n;
        v4u o; o.x = pk2(s[0 * 33], s[1 * 33]); o.y = pk2(s[2 * 33], s[3 * 33]); o.z = pk2(s[4 * 33], s[5 * 33]); o.w = pk2(s[6 * 33], s[7 * 33]);
        *(GAS v4u*)(WT + (size_t)(r0 + n) * K + k0 + 8 * c) = o; }
    LDS_WAIT(); asm volatile("" ::: "memory");
}
template <bool NORMALISE> __device__ __forceinline__ void row_to_bf16(const float* xrow, bf16* orow, float* ssp, int lane) {
    const GAS f32x4* xr = (const GAS f32x4*)xrow + lane;
    f32x4 v[4]; float s = 0.f;
#pragma unroll
    for (int j = 0; j < 4; ++j) { v[j] = xr[64 * j]; s += (v[j].x * v[j].x + v[j].y * v[j].y) + (v[j].z * v[j].z + v[j].w * v[j].w); }
    s = wave_sum(s);
    const float sc = NORMALISE ? 1.0f / sqrtf(s * (1.0f / 1024.0f) + EPSF) : 1.0f;
    GAS unsigned long long* o8 = (GAS unsigned long long*)orow + lane;
#pragma unroll
    for (int j = 0; j < 4; ++j) o8[64 * j] = (unsigned long long)pk2(v[j].x * sc, v[j].y * sc) | ((unsigned long long)pk2(v[j].z * sc, v[j].w * sc) << 32);
    if (ssp && lane == 0) *ssp = s;
}

__device__ __forceinline__ void scan_seq(Frame& F, const float* srcA, int LA, const float* srcB, int L, float* out, int pitch) {
    LAS float* tot = (LAS float*)(F.lds + RING_OFF);
    const int R = (L + 511) / 512, s0 = FTID * R;
    float a[8];
#pragma unroll
    for (int h = 0; h < 8; ++h) a[h] = 0.f;
    for (int i = 0; i < R; ++i) { const int s = s0 + i; if (s < L) { const float* p = (s < LA) ? srcA + (size_t)8 * s : srcB + (size_t)8 * (s - LA);
            const f32x4 x = *(const f32x4*)p, y = *(const f32x4*)(p + 4); a[0] += x.x; a[1] += x.y; a[2] += x.z; a[3] += x.w; a[4] += y.x; a[5] += y.y; a[6] += y.z; a[7] += y.w; } }
#pragma unroll
    for (int h = 0; h < 8; ++h) tot[FTID * 8 + h] = a[h];
    __syncthreads();
    {
        const int h = F.wave; float v[8], run = 0.f;
#pragma unroll
        for (int k = 0; k < 8; ++k) { v[k] = tot[(FLANE * 8 + k) * 8 + h]; run += v[k]; }
        float inc = run;
#pragma unroll
        for (int o = 1; o < 64; o <<= 1) { const float t = __shfl_up(inc, o); if (FLANE >= o) inc += t; }
        float pre = inc - run;
#pragma unroll
        for (int k = 0; k < 8; ++k) { tot[(FLANE * 8 + k) * 8 + h] = pre; pre += v[k]; }
    }
    __syncthreads();
#pragma unroll
    for (int h = 0; h < 8; ++h) a[h] = tot[FTID * 8 + h];
    for (int i = 0; i < R; ++i) { const int s = s0 + i; if (s < L) { const float* p = (s < LA) ? srcA + (size_t)8 * s : srcB + (size_t)8 * (s - LA);
            const f32x4 x = *(const f32x4*)p, y = *(const f32x4*)(p + 4); a[0] += x.x; a[1] += x.y; a[2] += x.z; a[3] += x.w; a[4] += y.x; a[5] += y.y; a[6] += y.z; a[7] += y.w;
#pragma unroll
            for (int h = 0; h < 8; ++h) out[(size_t)h * pitch + s] = a[h] * 1.4426950408889634f; } }
    __syncthreads();
}

#define PH_BEGIN unsigned char* ws = args.ws; float* out = args.out; asm volatile("" : "+s"(ws), "+s"(out))
#define CTLW ((gu32*)(ws + WS_CTL))
#define Wgu1 ((bf16*)(ws + WS_WGU1))
#define Wd1 ((bf16*)(ws + WS_WD1))
#define Win ((bf16*)(ws + WS_WIN))
#define Wout ((bf16*)(ws + WS_WOUT))
#define Wgu2 ((bf16*)(ws + WS_WGU2))
#define Wd2 ((bf16*)(ws + WS_WD2))
#define Wmkv ((bf16*)(ws + WS_WMKV))
#define MEMB ((bf16*)(ws + WS_MEMB))
#define MKb ((bf16*)(ws + WS_MK))
#define MVb ((bf16*)(ws + WS_MV))
#define FP2 ((float*)(ws + WS_FP2))
#define FS2 ((float*)(ws + WS_FS2))
#define SS1 ((float*)(ws + WS_SS1))
#define SS2 ((float*)(ws + WS_CTL) + CW_SS2)
#define SS3 ((float*)(ws + WS_CTL) + CW_SS3)
#define SS4 ((float*)(ws + WS_CTL) + CW_SS4)
#define SSD ((float*)(ws + WS_CTL) + CW_SSD)
#define XB ((bf16*)(ws + WS_XB))
#define ACT ((bf16*)(ws + WS_ACT))
#define Qb ((bf16*)(ws + WS_Q))
#define Kb ((bf16*)(ws + WS_K))
#define Vb ((bf16*)(ws + WS_V))
#define QMb ((bf16*)(ws + WS_QM))
#define CI ((float*)(ws + WS_CI))
#define BG ((bf16*)(ws + WS_BG))
#define MIX ((bf16*)(ws + WS_MIX))
#define X (out + O_Y)
__global__ void __launch_bounds__(NWAVES * 64, 2) hybrid_fwd(Args args) {
    extern __shared__ __attribute__((aligned(16))) unsigned char lds[];
    Frame F;
    F.lds = (LAS unsigned char*)lds;
    F.MISC = (volatile LAS unsigned*)(F.lds + MISC_OFF);
    F.wave = __builtin_amdgcn_readfirstlane((int)threadIdx.x >> 6);
    F.G = gridDim.x; { const int bx = blockIdx.x; F.vcu = (F.G % 8 == 0) ? (bx % 8) * (F.G / 8) + bx / 8 : bx; }
    for (int u = FTID; u < (LDS_BYTES - LDSCTL_OFF) / 4; u += NWAVES * 64) ((LAS unsigned*)(F.lds + LDSCTL_OFF))[u] = 0u;
    __syncthreads();
    if (N_LAUNCHES == 1) { PH_BEGIN; (void)out; (void)xcd_barrier_post((unsigned*)(CTLW + CW_BAR), F.MISC + 8, F.wave); }
#define GRID_BAR(seam) do { if (N_LAUNCHES == PER_PHASE) { if (FTID == 0) __hip_atomic_store(CTLW + CW_TMO, 0xBADBA0u | (unsigned)(seam), RLX_AGENT); } \
        else { XcdBarrier b_; b_.bar = (unsigned*)(CTLW + CW_BAR); b_.x = xb_xcc_id(); b_.st = F.MISC + 8; b_.wv = F.wave; xcd_barrier(b_); } } while (0)
    const int lo = (N_LAUNCHES == 1) ? 0 : args.ph_lo, hi = (N_LAUNCHES == 1) ? PER_PHASE : args.ph_hi;
#define IN(k) (lo <= (k) && (k) < hi)
#define NREP(k) ((PROBE_DUP == (k)) ? 2 : 1)
#define BOTH(k) (IN(k) && IN((k) + 1))
    const int gw = F.vcu * NWAVES + F.wave, NGW = F.G * NWAVES;

    for (int rep = 0; rep < NREP(0); ++rep) if (IN(0)) {
        PH_BEGIN;
        LAS float* scr = (LAS float*)(F.lds + RING_OFF + F.wave * 16384);
        constexpr int I_GU = 16 * 88, I_DN = 44 * 32, I_W256 = 16 * 8, I_W512 = 16 * 16, I_WO = 16 * 32;
        constexpr int NITEMS = 3 * I_GU + 3 * I_W256 + 3 * I_W512 + I_W256 + I_WO + 3 * I_GU + 2 * I_W256;
        static_assert(I_GU == I_DN, "items");
        for (int it = gw; it < NITEMS; it += NGW) {
            int r = it;
            if (r < I_GU) { p0_transpose_item(KARG(I_WG1), DFF, 1024, 0, DFF, Wgu1, SK_GATE, 0, KARG(I_NF1), scr, r, FLANE); continue; } r -= I_GU;
            if (r < I_GU) { p0_transpose_item(KARG(I_WU1), DFF, 1024, 0, DFF, Wgu1, SK_UP, 0, KARG(I_NF1), scr, r, FLANE); continue; } r -= I_GU;
            if (r < I_DN) { p0_transpose_item(KARG(I_WD1), 1024, DFF, 0, 1024, Wd1, SK_IDENT, 0, nullptr, scr, r, FLANE); continue; } r -= I_DN;
            if (r < I_W256) { p0_transpose_item(KARG(I_WIN), INCOLS, 1024, 0, 256, Win, SK_WIN_U, 0, KARG(I_NMIX), scr, r, FLANE); continue; } r -= I_W256;
            if (r < I_W256) { p0_transpose_item(KARG(I_WIN), INCOLS, 1024, 256, 256, Win, SK_WIN_C, 0, KARG(I_NMIX), scr, r, FLANE); continue; } r -= I_W256;
            if (r < I_W256) { p0_transpose_item(KARG(I_WIN), INCOLS, 1024, 512, 256, Win, SK_WIN_B, 0, KARG(I_NMIX), scr, r, FLANE); continue; } r -= I_W256;
            if (r < I_W512) { p0_transpose_item(KARG(I_WIN), INCOLS, 1024, 768, 512, Win, SK_HEADS, 0, KARG(I_NMIX), scr, r, FLANE); continue; } r -= I_W512;
            if (r < I_W512) { p0_transpose_item(KARG(I_WIN), INCOLS, 1024, 1280, 512, Win, SK_HEADS, 2, KARG(I_NMIX), scr, r, FLANE); continue; } r -= I_W512;
            if (r < I_W512) { p0_transpose_item(KARG(I_WIN), INCOLS, 1024, 1792, 512, Win, SK_HEADS, 4, KARG(I_NMIX), scr, r, FLANE); continue; } r -= I_W512;
            if (r < I_W256) { p0_transpose_item(KARG(I_WIN), INCOLS, 1024, 2312, 256, Win, SK_HEADS, 6, KARG(I_NMIX), scr, r, FLANE); continue; } r -= I_W256;
            if (r < I_WO) { p0_transpose_item(KARG(I_WOUT), 1024, 1024, 0, 1024, Wout, SK_IDENT, 0, nullptr, scr, r, FLANE); continue; } r -= I_WO;
            if (r < I_GU) { p0_transpose_item(KARG(I_WG2), DFF, 1024, 0, DFF, Wgu2, SK_GATE, 0, KARG(I_NF2), scr, r, FLANE); continue; } r -= I_GU;
            if (r < I_GU) { p0_transpose_item(KARG(I_WU2), DFF, 1024, 0, DFF, Wgu2, SK_UP, 0, KARG(I_NF2), scr, r, FLANE); continue; } r -= I_GU;
            if (r < I_DN) { p0_transpose_item(KARG(I_WD2), 1024, DFF, 0, 1024, Wd2, SK_IDENT, 0, nullptr, scr, r, FLANE); continue; } r -= I_DN;
            if (r < I_W256) { p0_transpose_item(KARG(I_WMKV), 512, 1024, 0, 256, Wmkv, SK_HEADS, 0, KARG(I_NMEM), scr, r, FLANE); continue; } r -= I_W256;
            p0_transpose_item(KARG(I_WMKV), 512, 1024, 256, 256, Wmkv, SK_HEADS, 1, KARG(I_NMEM), scr, r, FLANE);
        }
        for (int i = blockIdx.x * (NWAVES * 64) + FTID; i < 256 * 1024 / 2; i += F.G * NWAVES * 64) {
            const int rr = (2 * i) >> 10, k = (2 * i) & 1023; unsigned w = 0u;
            if (rr < 8) { const float* wi = KARG(I_WIN); const float* g = KARG(I_NMIX); w = pk2(wi[(size_t)k * INCOLS + 2304 + rr] * g[k], wi[(size_t)(k + 1) * INCOLS + 2304 + rr] * g[k + 1]); }
            *(unsigned*)(Win + (size_t)(2560 + rr) * 1024 + k) = w;
        }
        if (blockIdx.x == 0) {
            float* par = (float*)(ws + WS_PAR);
            for (int i = FTID; i < PAR_N; i += NWAVES * 64) { float v = 0.f;
                if (i < 64) v = KARG(I_GQF)[i]; else if (i < 128) v = KARG(I_GKF)[i - 64]; else if (i < 192) v = KARG(I_GQM)[i - 128]; else if (i < 256) v = KARG(I_GKM)[i - 192];
                else if (i < 264) v = KARG(I_BF)[i - 256]; else if (i >= PAR_CW && i < PAR_CW + 768) v = KARG(I_CW)[i - PAR_CW]; else if (i >= PAR_CB && i < PAR_CB + 256) v = KARG(I_CB)[i - PAR_CB];
                else if (i >= PAR_GFIN) v = KARG(I_NFIN)[i - PAR_GFIN];
                par[i] = v; }
            if (F.wave == 0) {
                float a = fabsf(KARG(I_GQF)[FLANE]), b = fabsf(KARG(I_GKF)[FLANE]);
#pragma unroll
                for (int o = 1; o < 64; o <<= 1) { a = fmaxf(a, __shfl_xor(a, o)); b = fmaxf(b, __shfl_xor(b, o)); }
                if (FLANE == 0) par[PAR_THR] = (104.0f + 2.0f * 8.0f * a * b * 1.02f) * 1.4426950408889634f; }
        }
        for (int m = gw; m < M; m += NGW) row_to_bf16<false>(m < MP ? KARG(I_XP) + (size_t)m * 1024 : KARG(I_XS) + (size_t)(m - MP) * 1024, XB + (size_t)m * 1024, SS1 + m, FLANE);
        for (int m = gw; m < MMEM; m += NGW) row_to_bf16<true>(KARG(I_MEMP) + (size_t)m * 1024, MEMB + (size_t)m * 1024, nullptr, FLANE);
        if (BOTH(0)) GRID_BAR(0);
    }

    for (int rep = 0; rep < NREP(1); ++rep) if (IN(1)) {
        PH_BEGIN;
        { pg8::Gemm g{XB, Wgu1, M, NGU, 1024}; pg8::StaticOrder S; S.init(M, NGU, F.G, (int)blockIdx.x);
          pg8::EpiSwiGLU E{ACT, SS1};
          pg8::gemm_phase<pg8::EpiSwiGLU, pg8::StaticOrder, true, true>(F.lds + RING_OFF, g, S, E, F.wave); }
        { pg8::Gemm g{MEMB, Wmkv, MMEM, 512, 1024}; pg8::StaticOrder S; S.init(MMEM, 512, F.G, (int)((blockIdx.x + F.G - 216) % F.G));
          pg8::EpiMemKV E{ws, out};
          pg8::gemm_phase<pg8::EpiMemKV, pg8::StaticOrder, true, true>(F.lds + RING_OFF, g, S, E, F.wave); }
        if (BOTH(1)) GRID_BAR(1);
    }

    for (int rep = 0; rep < NREP(2); ++rep) if (IN(2)) {
        PH_BEGIN;
        pg8::Gemm g{ACT, Wd1, M, 1024, DFF}; pg8::StaticOrder S; S.init(M, 1024, F.G, (int)blockIdx.x);
        pg8::EpiResid E{KARG(I_XP), KARG(I_XS), X, XB, rep ? SSD : SS2, 0.5f};
        pg8::gemm_phase<pg8::EpiResid, pg8::StaticOrder, true, true>(F.lds + RING_OFF, g, S, E, F.wave);
        if (BOTH(2)) GRID_BAR(2);
    }

    for (int rep = 0; rep < NREP(3); ++rep) if (IN(3)) {
        PH_BEGIN;
        pg8::Gemm g{XB, Win, M, NIN, 1024}; pg8::StaticOrder S; S.init(M, NIN, F.G, (int)blockIdx.x);
        pg8::EpiWin E{ws, out};
        pg8::gemm_phase<pg8::EpiWin, pg8::StaticOrder, true, true>(F.lds + RING_OFF, g, S, E, F.wave);
        if (BOTH(3)) GRID_BAR(3);
    }

    for (int rep = 0; rep < NREP(4); ++rep) if (IN(4)) {
        PH_BEGIN;
        for (int u = blockIdx.x; u < NB + DB; u += F.G) {
            if (u < NB) scan_seq(F, out + O_LFP + (size_t)u * SEQ * 8, SEQ, nullptr, SEQ, FP2 + (size_t)u * 8 * SEQ, SEQ);
            else { const int b = u - NB; scan_seq(F, KARG(I_CFLF) + (size_t)b * PAST * 8, PAST, out + O_LFS + (size_t)b * DS * 8, PAST + DS, FS2 + (size_t)b * 8 * FSP, FSP); }
        }
        {
            const float* cw = (const float*)(ws + WS_PAR) + PAR_CW; const float* cb = (const float*)(ws + WS_PAR) + PAR_CB; const float* sc = KARG(I_SCONV);
            for (int i = blockIdx.x * (NWAVES * 64) + FTID; i < M * 32; i += F.G * NWAVES * 64) {
                const int row = i >> 5, ch = (i & 31) * 8;
                int t, T; const float* st = nullptr; float* ns;
                if (row < MP) { t = row & (SEQ - 1); T = SEQ; ns = out + O_CSP + (size_t)(row >> 13) * 512; }
                else { const int b = (row - MP) >> 5; t = (row - MP) & 31; T = DS; st = sc + (size_t)b * 512; ns = out + O_CSS + (size_t)b * 512; }
                const float* cp = CI + (size_t)row * 256 + ch;
                f32x4 c2[2] = {*(const f32x4*)cp, *(const f32x4*)(cp + 4)}, c1[2], c0[2];
                if (t >= 1) { c1[0] = *(const f32x4*)(cp - 256); c1[1] = *(const f32x4*)(cp - 252); }
                else if (st) { c1[0] = *(const f32x4*)(st + 256 + ch); c1[1] = *(const f32x4*)(st + 256 + ch + 4); }
                else { c1[0] = (f32x4){0.f, 0.f, 0.f, 0.f}; c1[1] = c1[0]; }
                if (t >= 2) { c0[0] = *(const f32x4*)(cp - 512); c0[1] = *(const f32x4*)(cp - 508); }
                else if (st) { c0[0] = *(const f32x4*)(st + (size_t)t * 256 + ch); c0[1] = *(const f32x4*)(st + (size_t)t * 256 + ch + 4); }
                else { c0[0] = (f32x4){0.f, 0.f, 0.f, 0.f}; c0[1] = c0[0]; }
                const v4u bgw = *(const v4u*)(BG + (size_t)row * 256 + ch);
                f32x4 y[2];
#pragma unroll
                for (int hh = 0; hh < 2; ++hh) {
                    const f32x4 w0 = *(const f32x4*)(cw + ch + 4 * hh), w1 = *(const f32x4*)(cw + 256 + ch + 4 * hh), w2 = *(const f32x4*)(cw + 512 + ch + 4 * hh), bb = *(const f32x4*)(cb + ch + 4 * hh);
                    const unsigned g0 = hh ? bgw.z : bgw.x, g1 = hh ? bgw.w : bgw.y;
                    const f32x4 gate = {__uint_as_float(g0 << 16), __uint_as_float(g0 & 0xffff0000u), __uint_as_float(g1 << 16), __uint_as_float(g1 & 0xffff0000u)};
                    y[hh] = gate * (bb + w0 * c0[hh] + w1 * c1[hh] + w2 * c2[hh]);
                }
                v4u o; o.x = pk2(y[0].x, y[0].y); o.y = pk2(y[0].z, y[0].w); o.z = pk2(y[1].x, y[1].y); o.w = pk2(y[1].z, y[1].w);
                *(v4u*)(MIX + (size_t)row * 1024 + ch) = o;
                if (t >= T - 2) { float* np = ns + (size_t)(t - (T - 2)) * 256 + ch; *(f32x4*)np = c2[0]; *(f32x4*)(np + 4) = c2[1]; }
            }
        }
        if (BOTH(4)) GRID_BAR(4);
    }


    for (int rep = 0; rep < NREP(5); ++rep) if (IN(5)) {
        PH_BEGIN;
        typedef attn_body::bf16 abf;
        char* shm = (char*)lds + RING_OFF; char* aux = (char*)lds + SAUX_OFF;
        for (int u = F.vcu; u < DB * FOXH; u += F.G) {
            const int b = u >> 3, h = u & 7;
            struct Tiles { const float *ck, *cv, *nk, *nv, *f2; float fr;
                __device__ __forceinline__ int ntiles(int w) const { return w == 7 ? 3 : 2; }
                __device__ __forceinline__ void tile(int w, int i, const float*& ks, const float*& vs, int& rstride, int& nvalid, const float*& bias, bool& cn) const {
                    if (i < 2) { const int t = 2 * w + i; ks = ck + (size_t)t * 64 * 512; vs = cv + (size_t)t * 64 * 512; rstride = 512; nvalid = 64; bias = f2 + 64 * t; cn = false; }
                    else { ks = nk; vs = nv; rstride = 512; nvalid = DS; bias = f2 + PAST; cn = true; } }
                __device__ __forceinline__ float fref() const { return fr; } };
            const float* f2 = FS2 + (size_t)(b * 8 + h) * FSP;
            Tiles T{KARG(I_CFK) + ((size_t)b * PAST * 8 + h) * 64, KARG(I_CFV) + ((size_t)b * PAST * 8 + h) * 64,
                    out + O_FKS + ((size_t)b * DS * 8 + h) * 64, out + O_FVS + ((size_t)b * DS * 8 + h) * 64, f2, f2[PAST]};
            attn_body::samp_unit(T, (const abf*)Qb + (size_t)(MP + b * DS) * 512 + h * 64, 512, (abf*)MIX + (size_t)(MP + b * DS) * 1024 + 256 + h * 64, 1024, shm, aux, F.wave);
        }
        for (int u = F.vcu; u < DB * MEMH; u += F.G) {
            const int b = u >> 2, h = u & 3;
            struct Tiles { const float *ck, *cv;
                __device__ __forceinline__ int ntiles(int w) const { return w < 4 ? 1 : 0; }
                __device__ __forceinline__ void tile(int w, int, const float*& ks, const float*& vs, int& rstride, int& nvalid, const float*& bias, bool& cn) const {
                    ks = ck + (size_t)w * 64 * 256; vs = cv + (size_t)w * 64 * 256; rstride = 256; nvalid = 64; bias = nullptr; cn = false; }
                __device__ __forceinline__ float fref() const { return 0.f; } };
            Tiles T{KARG(I_CMK) + ((size_t)b * NMEM * 4 + h) * 64, KARG(I_CMV) + ((size_t)b * NMEM * 4 + h) * 64};
            attn_body::samp_unit(T, (const abf*)QMb + (size_t)(MP + b * DS) * 256 + h * 64, 256, (abf*)MIX + (size_t)(MP + b * DS) * 1024 + 768 + h * 64, 1024, shm, aux, F.wave);
        }
        for (int u = F.vcu; u < NB * MEMH * 32; u += F.G) {
            const int b = u >> 7, h = (u >> 5) & 3, qb = u & 31; const size_t r0 = (size_t)b * SEQ + qb * 256;
            attn_body::attn_unit<8, false, false, 256, 256, 1024>((const abf*)QMb + r0 * 256 + h * 64, (const abf*)MKb + (size_t)b * NMEM * 256 + h * 64, (const abf*)MVb + (size_t)b * NMEM * 256 + h * 64,
                                                                 (abf*)MIX + r0 * 1024 + 768 + h * 64, 4, nullptr, 0, 0, shm, F.wave);
        }
        for (int u = F.vcu; u < NB * FOXH * 16; u += F.G) {
            const int bh = u >> 4, b = bh >> 3, h = bh & 7, s = u & 15;
            for (int k = 0; k < 2; ++k) {
                const int qb = k ? 31 - s : s; const size_t r0 = (size_t)b * SEQ + qb * 256;
                const float* F2 = FP2 + (size_t)bh * SEQ; const int NTfull = 4 * qb + 4; int t0 = 0;
                if (NTfull > 4) { const float thr = F2[qb * 256] + ((const float*)(ws + WS_PAR))[PAR_THR]; const int ln = FLANE, j0 = ln, j1 = ln + 64;
                    const bool sk0 = (j0 < NTfull - 4) && (F2[64 * j0 + 63] >= thr), sk1 = (j1 < NTfull - 4) && (F2[64 * j1 + 63] >= thr);
                    t0 = (__builtin_popcountll(__ballot(sk0)) + __builtin_popcountll(__ballot(sk1))) & ~1; t0 = __builtin_amdgcn_readfirstlane(t0); }
                attn_body::attn_unit<8, true, true, 512, 512, 1024>((const abf*)Qb + r0 * 512 + h * 64, (const abf*)Kb + ((size_t)b * SEQ + 64 * t0) * 512 + h * 64, (const abf*)Vb + ((size_t)b * SEQ + 64 * t0) * 512 + h * 64,
                                                                   (abf*)MIX + r0 * 1024 + 256 + h * 64, NTfull - t0, F2, 64 * t0, qb * 256, shm, F.wave);
            }
        }
        if (BOTH(5)) GRID_BAR(5);
    }

    for (int rep = 0; rep < NREP(6); ++rep) if (IN(6)) {
        PH_BEGIN;
        pg8::Gemm g{MIX, Wout, M, 1024, 1024}; pg8::StaticOrder S; S.init(M, 1024, F.G, (int)blockIdx.x);
        pg8::EpiResid E{X, X + (size_t)MP * 1024, X, XB, rep ? SSD : SS3, rep ? 0.f : 1.0f};
        pg8::gemm_phase<pg8::EpiResid, pg8::StaticOrder, true, true>(F.lds + RING_OFF, g, S, E, F.wave);
        if (BOTH(6)) GRID_BAR(6);
    }

    for (int rep = 0; rep < NREP(7); ++rep) if (IN(7)) {
        PH_BEGIN;
        pg8::Gemm g{XB, Wgu2, M, NGU, 1024}; pg8::StaticOrder S; S.init(M, NGU, F.G, (int)blockIdx.x);
        pg8::EpiSwiGLU E{ACT, SS3};
        pg8::gemm_phase<pg8::EpiSwiGLU, pg8::StaticOrder, true, true>(F.lds + RING_OFF, g, S, E, F.wave);
        if (BOTH(7)) GRID_BAR(7);
    }

    for (int rep = 0; rep < NREP(8); ++rep) if (IN(8)) {
        PH_BEGIN;
        pg8::Gemm g{ACT, Wd2, M, 1024, DFF}; pg8::StaticOrder S; S.init(M, 1024, F.G, (int)blockIdx.x);
        pg8::EpiResid E{X, X + (size_t)MP * 1024, X, nullptr, rep ? SSD : SS4, rep ? 0.f : 0.5f};
        pg8::gemm_phase<pg8::EpiResid, pg8::StaticOrder, true, true>(F.lds + RING_OFF, g, S, E, F.wave);
        if (BOTH(8)) GRID_BAR(8);
    }

    for (int rep = 0; rep < NREP(9); ++rep) if (IN(9)) {
        PH_BEGIN;
        const float* gf = (const float*)(ws + WS_PAR) + PAR_GFIN;
        unsigned bad = __hip_atomic_load(CTLW + CW_TMO, RLX_AGENT) | __hip_atomic_load((gu32*)((unsigned*)(CTLW + CW_BAR) + XB_TMO), RLX_AGENT);
        if (N_LAUNCHES == PER_PHASE) bad = 0u;
        for (int m = gw; m < M; m += NGW) {
            const float rs = bad ? __builtin_nanf("") : 1.0f / sqrtf(SS4[m] * (1.0f / 1024.0f) + EPSF);
            GAS f32x4* xr = (GAS f32x4*)(X + (size_t)m * 1024) + FLANE; const GAS f32x4* gr = (const GAS f32x4*)gf + FLANE;
#pragma unroll
            for (int j = 0; j < 4; ++j) xr[64 * j] = xr[64 * j] * rs * gr[64 * j];
        }
    }
#undef IN
#undef BOTH
#undef GRID_BAR
}

extern "C" void kernel_launch(void* const* d_in, const int* in_sizes, int n_in, void* d_out, int out_size, void* d_ws, size_t ws_size, hipStream_t stream) {
    static int grid = 0;
    if (grid == 0) {
        if (n_in != 30 || in_sizes[0] != MP * 1024 || out_size != (int)O_END || ws_size < WS_END) { fprintf(stderr, "kernel_launch: built for 30 inputs, %d x floats, %zu outputs, >= %zu bytes of workspace; got n_in %d, in0 %d, out %d, ws %zu; nothing launched\n", MP * 1024, (size_t)O_END, (size_t)WS_END, n_in, n_in > 0 ? in_sizes[0] : -1, out_size, ws_size); grid = -1; return; }
        int dev = 0, cus = 0, per_cu = 0;
        if (hipGetDevice(&dev) != hipSuccess || hipDeviceGetAttribute(&cus, hipDeviceAttributeMultiprocessorCount, dev) != hipSuccess) { fprintf(stderr, "kernel_launch: hipGetDevice / hipDeviceGetAttribute failed; nothing launched\n"); grid = -1; return; }
        if (hipFuncSetAttribute((const void*)hybrid_fwd, hipFuncAttributeMaxDynamicSharedMemorySize, LDS_BYTES) != hipSuccess) { fprintf(stderr, "kernel_launch: hipFuncSetAttribute failed (%d bytes of dynamic LDS); nothing launched\n", LDS_BYTES); grid = -1; return; }
        if (hipOccupancyMaxActiveBlocksPerMultiprocessor(&per_cu, (const void*)hybrid_fwd, NWAVES * 64, LDS_BYTES) != hipSuccess || per_cu < 1)
            fprintf(stderr, "kernel_launch: note: the occupancy query reports %d workgroups per CU; launching one per CU (%d bytes of LDS each)\n", per_cu, LDS_BYTES);
        (void)hipGetLastError();
        grid = cus;
        if (grid != 256) fprintf(stderr, "kernel_launch: note: %d CUs (the unit deals are tuned for 256)\n", grid);
    }
    if (grid < 0) return;
    if (hipMemsetAsync((char*)d_ws + WS_CTL, 0, CTL_ZERO_BYTES, stream) != hipSuccess) { fprintf(stderr, "kernel_launch: hipMemsetAsync of the control words failed; nothing launched\n"); return; }
    Args a{};
    for (int i = 0; i < 30; ++i) a.in[i] = (const float*)d_in[i];
    a.out = (float*)d_out; a.ws = (unsigned char*)d_ws;
    for (int li = 0; li < N_LAUNCHES; ++li) {
        a.ph_lo = (N_LAUNCHES == PER_PHASE) ? li : 0; a.ph_hi = (N_LAUNCHES == PER_PHASE) ? li + 1 : PER_PHASE;
        hipLaunchKernelGGL(hybrid_fwd, dim3(grid), dim3(NWAVES * 64), LDS_BYTES, stream, a);
        const hipError_t le = hipPeekAtLastError();
        if (le != hipSuccess) { fprintf(stderr, "kernel_launch: launch %d failed: %s (grid %d x %d threads, %d B LDS)\n", li, hipGetErrorName(le), grid, NWAVES * 64, LDS_BYTES); break; }
    }
}
```
